# Optimizing an MI355X kernel written in HIP

```python
import math
import jax
import jax.numpy as jnp
from jax import lax
import numpy as np

D_MODEL = 1024
BATCH = 8
SEQ = 4096
DEPTH = 4

CHUNK = 64
Q_BLOCK = 128
HEAD_DIM = 64
FOX_HEADS = D_MODEL // HEAD_DIM
DIFF_HEADS = D_MODEL // (2 * HEAD_DIM)
ROT_DIM = HEAD_DIM // 4
ROPE_THETA = 500000.0
CONV_WIDTH = 31
D_FF = ((8 * D_MODEL // 3 + 127) // 128) * 128
N_MIXERS = 3
N_FOX = (DEPTH + 2) // 3
N_CONV = (DEPTH + 1) // 3
N_DIFF = DEPTH // 3
EPS = 1e-6

kernel_name = 'hybrid_fox_conformer_diffattn_trunk'


def _rms_norm(x, g):
    xf = x.astype(jnp.float32)
    y = xf * lax.rsqrt(jnp.mean(xf * xf, axis=-1, keepdims=True) + EPS)
    return (y * g.astype(jnp.float32)).astype(x.dtype)


def _layer_norm(x, g, b):
    xf = x.astype(jnp.float32)
    mu = jnp.mean(xf, axis=-1, keepdims=True)
    var = jnp.mean(jnp.square(xf - mu), axis=-1, keepdims=True)
    y = (xf - mu) * lax.rsqrt(var + EPS)
    return (y * g.astype(jnp.float32) + b.astype(jnp.float32)).astype(x.dtype)


def _swiglu(h, w_gate, w_up, w_down):
    return (jax.nn.silu(h @ w_gate) * (h @ w_up)) @ w_down


def _partial_rope(x, cos, sin):
    half = ROT_DIM // 2
    x1 = x[..., :half]
    x2 = x[..., half:ROT_DIM]
    xp = x[..., ROT_DIM:]
    return jnp.concatenate([x1 * cos - x2 * sin, x2 * cos + x1 * sin, xp], axis=-1)


def _fox_mixer(h, w_in, b_f, q_gain, k_gain, w_out):
    bsz, seq, _ = h.shape
    proj = h @ w_in
    q = proj[..., :D_MODEL].reshape(bsz, seq, FOX_HEADS, HEAD_DIM)
    k = proj[..., D_MODEL:2 * D_MODEL].reshape(bsz, seq, FOX_HEADS, HEAD_DIM)
    v = proj[..., 2 * D_MODEL:3 * D_MODEL].reshape(bsz, seq, FOX_HEADS, HEAD_DIM)
    f_logit = proj[..., 3 * D_MODEL:] + b_f
    q = _rms_norm(q, q_gain)
    k = _rms_norm(k, k_gain)
    log_f = jax.nn.log_sigmoid(f_logit.astype(jnp.float32))
    cum = jnp.cumsum(log_f, axis=1).transpose(0, 2, 1)
    scale = HEAD_DIM ** -0.5
    outs = []
    for q0 in range(0, seq, Q_BLOCK):
        q1 = q0 + Q_BLOCK
        s = jnp.einsum('bqhd,bkhd->bhqk', q[:, q0:q1], k[:, :q1]).astype(jnp.float32) * scale
        s = s + cum[:, :, q0:q1, None] - cum[:, :, None, :q1]
        causal = jnp.arange(q1)[None, :] <= jnp.arange(q0, q1)[:, None]
        p = jax.nn.softmax(jnp.where(causal, s, -jnp.inf), axis=-1)
        outs.append(jnp.einsum('bhqk,bkhd->bqhd', p.astype(v.dtype), v[:, :q1]))
    o = jnp.concatenate(outs, axis=1).reshape(bsz, seq, D_MODEL)
    return o @ w_out


def _conv_module(h, w_pw1, b_pw1, w_dw, b_dw, ln_g, ln_b, w_pw2, b_pw2):
    u = h @ w_pw1 + b_pw1
    u = u[..., :D_MODEL] * jax.nn.sigmoid(u[..., D_MODEL:])
    u = lax.conv_general_dilated(
        u, w_dw[:, None, :].astype(u.dtype), window_strides=(1,),
        padding=[(CONV_WIDTH - 1, 0)], dimension_numbers=('NWC', 'WIO', 'NWC'),
        feature_group_count=D_MODEL) + b_dw
    u = jax.nn.silu(_layer_norm(u, ln_g, ln_b))
    return u @ w_pw2 + b_pw2


def _diff_mixer(h, cos, sin, w_in, q_gain, k_gain, lam_q1, lam_k1, lam_q2, lam_k2,
                sub_gain, w_out, lambda_init):
    bsz, seq, _ = h.shape
    proj = h @ w_in
    q = proj[..., :D_MODEL].reshape(bsz, seq, DIFF_HEADS, 2, HEAD_DIM)
    k = proj[..., D_MODEL:2 * D_MODEL].reshape(bsz, seq, DIFF_HEADS, 2, HEAD_DIM)
    v = proj[..., 2 * D_MODEL:].reshape(bsz, seq, DIFF_HEADS, 2 * HEAD_DIM)
    q = _partial_rope(_rms_norm(q, q_gain), cos, sin)
    k = _partial_rope(_rms_norm(k, k_gain), cos, sin)
    lam = (jnp.exp(jnp.sum(lam_q1.astype(jnp.float32) * lam_k1.astype(jnp.float32)))
           - jnp.exp(jnp.sum(lam_q2.astype(jnp.float32) * lam_k2.astype(jnp.float32)))
           + lambda_init)
    scale = HEAD_DIM ** -0.5
    outs = []
    for q0 in range(0, seq, Q_BLOCK):
        q1 = q0 + Q_BLOCK
        s = jnp.einsum('bqhmd,bkhmd->bhmqk', q[:, q0:q1], k[:, :q1]).astype(jnp.float32) * scale
        visible = (jnp.arange(q1)[None, :] // CHUNK) <= (jnp.arange(q0, q1)[:, None] // CHUNK)
        p = jax.nn.softmax(jnp.where(visible, s, -jnp.inf), axis=-1)
        a = p[:, :, 0] - lam * p[:, :, 1]
        outs.append(jnp.einsum('bhqk,bkhe->bqhe', a.astype(v.dtype), v[:, :q1]))
    o = jnp.concatenate(outs, axis=1)
    o = _rms_norm(o, sub_gain) * (1.0 - lambda_init)
    return o.reshape(bsz, seq, D_MODEL) @ w_out


def setup_inputs(seed: int = 0) -> dict:
    key = jax.random.key(seed)
    ks = iter(list(jax.random.split(key, 40)))
    f32 = jnp.float32

    def nrm(shape, fan_in):
        return jax.random.normal(next(ks), shape, f32) * (fan_in ** -0.5)

    def gain(shape):
        return 1.0 + 0.05 * jax.random.normal(next(ks), shape, f32)

    def bias(shape):
        return 0.02 * jax.random.normal(next(ks), shape, f32)

    x = jax.random.normal(next(ks), (BATCH, SEQ, D_MODEL), f32)
    offset = CHUNK * jax.random.randint(next(ks), (BATCH, 1), 0, 64, dtype=jnp.int32)
    positions = (jnp.arange(SEQ, dtype=jnp.int32)[None, :] + offset).astype(jnp.int32)
    return {
        'x': x,
        'positions': positions,
        'norm_ffn1': gain((DEPTH, D_MODEL)),
        'norm_mix': gain((DEPTH, D_MODEL)),
        'norm_ffn2': gain((DEPTH, D_MODEL)),
        'ffn1_w_gate': nrm((DEPTH, D_MODEL, D_FF), D_MODEL),
        'ffn1_w_up': nrm((DEPTH, D_MODEL, D_FF), D_MODEL),
        'ffn1_w_down': nrm((DEPTH, D_FF, D_MODEL), D_FF),
        'ffn2_w_gate': nrm((DEPTH, D_MODEL, D_FF), D_MODEL),
        'ffn2_w_up': nrm((DEPTH, D_MODEL, D_FF), D_MODEL),
        'ffn2_w_down': nrm((DEPTH, D_FF, D_MODEL), D_FF),
        'fox_w_in': nrm((N_FOX, D_MODEL, 3 * D_MODEL + FOX_HEADS), D_MODEL),
        'fox_b_f': 1.0 + 3.0 * jax.random.uniform(next(ks), (N_FOX, FOX_HEADS), f32),
        'fox_q_gain': gain((N_FOX, HEAD_DIM)),
        'fox_k_gain': gain((N_FOX, HEAD_DIM)),
        'fox_w_out': nrm((N_FOX, D_MODEL, D_MODEL), D_MODEL),
        'conv_w_pw1': nrm((N_CONV, D_MODEL, 2 * D_MODEL), D_MODEL),
        'conv_b_pw1': bias((N_CONV, 2 * D_MODEL)),
        'conv_w_dw': nrm((N_CONV, CONV_WIDTH, D_MODEL), CONV_WIDTH),
        'conv_b_dw': bias((N_CONV, D_MODEL)),
        'conv_ln_g': gain((N_CONV, D_MODEL)),
        'conv_ln_b': bias((N_CONV, D_MODEL)),
        'conv_w_pw2': nrm((N_CONV, D_MODEL, D_MODEL), D_MODEL),
        'conv_b_pw2': bias((N_CONV, D_MODEL)),
        'diff_w_in': nrm((N_DIFF, D_MODEL, 3 * D_MODEL), D_MODEL),
        'diff_q_gain': gain((N_DIFF, HEAD_DIM)),
        'diff_k_gain': gain((N_DIFF, HEAD_DIM)),
        'diff_lambda_q1': 0.1 * jax.random.normal(next(ks), (N_DIFF, HEAD_DIM), f32),
        'diff_lambda_k1': 0.1 * jax.random.normal(next(ks), (N_DIFF, HEAD_DIM), f32),
        'diff_lambda_q2': 0.1 * jax.random.normal(next(ks), (N_DIFF, HEAD_DIM), f32),
        'diff_lambda_k2': 0.1 * jax.random.normal(next(ks), (N_DIFF, HEAD_DIM), f32),
        'diff_sub_gain': gain((N_DIFF, 2 * HEAD_DIM)),
        'diff_w_out': nrm((N_DIFF, D_MODEL, D_MODEL), D_MODEL),
    }


def reference(x, positions, norm_ffn1, norm_mix, norm_ffn2,
              ffn1_w_gate, ffn1_w_up, ffn1_w_down, ffn2_w_gate, ffn2_w_up, ffn2_w_down,
              fox_w_in, fox_b_f, fox_q_gain, fox_k_gain, fox_w_out,
              conv_w_pw1, conv_b_pw1, conv_w_dw, conv_b_dw, conv_ln_g, conv_ln_b,
              conv_w_pw2, conv_b_pw2,
              diff_w_in, diff_q_gain, diff_k_gain, diff_lambda_q1, diff_lambda_k1,
              diff_lambda_q2, diff_lambda_k2, diff_sub_gain, diff_w_out):
    inv_freq = ROPE_THETA ** (-jnp.arange(0, ROT_DIM, 2, dtype=jnp.float32) / ROT_DIM)
    ang = positions.astype(jnp.float32)[..., None] * inv_freq
    cos = jnp.cos(ang)[:, :, None, None, :].astype(x.dtype)
    sin = jnp.sin(ang)[:, :, None, None, :].astype(x.dtype)

    i_fox = 0
    i_conv = 0
    i_diff = 0
    for i in range(DEPTH):
        x = x + 0.5 * _swiglu(_rms_norm(x, norm_ffn1[i]), ffn1_w_gate[i], ffn1_w_up[i], ffn1_w_down[i])
        h = _rms_norm(x, norm_mix[i])
        kind = i % N_MIXERS
        if kind == 0:
            y = _fox_mixer(h, fox_w_in[i_fox], fox_b_f[i_fox], fox_q_gain[i_fox],
                           fox_k_gain[i_fox], fox_w_out[i_fox])
            i_fox += 1
        elif kind == 1:
            y = _conv_module(h, conv_w_pw1[i_conv], conv_b_pw1[i_conv], conv_w_dw[i_conv],
                             conv_b_dw[i_conv], conv_ln_g[i_conv], conv_ln_b[i_conv],
                             conv_w_pw2[i_conv], conv_b_pw2[i_conv])
            i_conv += 1
        else:
            lambda_init = 0.8 - 0.6 * math.exp(-0.3 * i)
            y = _diff_mixer(h, cos, sin, diff_w_in[i_diff], diff_q_gain[i_diff],
                            diff_k_gain[i_diff], diff_lambda_q1[i_diff], diff_lambda_k1[i_diff],
                            diff_lambda_q2[i_diff], diff_lambda_k2[i_diff],
                            diff_sub_gain[i_diff], diff_w_out[i_diff], lambda_init)
            i_diff += 1
        x = x + y
        x = x + 0.5 * _swiglu(_rms_norm(x, norm_ffn2[i]), ffn2_w_gate[i], ffn2_w_up[i], ffn2_w_down[i])
    return x
```

```cpp
#include <hip/hip_runtime.h>
#include <hip/hip_cooperative_groups.h>
#include <hip/hip_bf16.h>
#include <cstdio>
#include <cstdint>
#include <cmath>
__device__ __forceinline__ int otid() { int t = threadIdx.x; asm volatile("" : "+v"(t)); return t; }
namespace pg8 {
#define PG8_LAS __attribute__((address_space(3)))
typedef unsigned short bf16_t;
typedef short bf16x8 __attribute__((ext_vector_type(8)));
typedef float f32x4 __attribute__((ext_vector_type(4)));
typedef unsigned u32x4 __attribute__((ext_vector_type(4)));
constexpr int BM = 256, BK = 64, HALF = 128, HTB = HALF * BK * 2  , STAGE_BYTES = 8 * HTB, NXCD = 8, WGM = 8;

__host__ __device__ __forceinline__ int lds_byte(int r, int c) { const int st = (r >> 4) * 2 + (c >> 5), rr = r & 15, cc = c & 31, ob = rr * 64 + cc * 2; return st * 1024 + (ob ^ (((ob >> 9) & 1) << 5)); }
__host__ __device__ __forceinline__ void stage_rc(int b, int& R, int& C) { const int st = b / 1024, sb = b % 1024, swz = sb ^ (((sb >> 9) & 1) << 5); R = (st >> 1) * 16 + swz / 64; C = (st & 1) * 32 + (swz % 64) / 2; }
__host__ __device__ __forceinline__ int perm32(int rho) { const int n = rho >> 4, i = rho & 15; return 8 * (i >> 2) + 4 * n + (i & 3); }

struct Unit { int pm, pn; };
struct Gemm { const bf16_t* A; const bf16_t* Bt; int M, N, K; };

struct StaticOrder {
    int nM, nN, nwg, G, c;
    __host__ __device__ void init(int M, int N, int G_, int c_) { nM = M / BM; nN = N / BM; nwg = nM * nN; G = G_; c = c_; }
    __host__ __device__ bool next(int i, Unit& u) const {
        const long L = (long)i * G + c; if (L >= nwg) return false;
        int wgid = (int)L; { const int q = nwg / NXCD, r = nwg % NXCD, xcd = wgid % NXCD, off = wgid / NXCD; wgid = (xcd < r ? xcd * (q + 1) : r * (q + 1) + (xcd - r) * q) + off; }
        const int nig = WGM * nN, gid = wgid / nig, fm = gid * WGM, gsz = (nM - fm) < WGM ? (nM - fm) : WGM;
        u.pm = fm + ((wgid % nig) % gsz); u.pn = (wgid % nig) / gsz; return true;
    }
    __device__ __forceinline__ void a_ready(const Unit&) const {}
    __device__ __forceinline__ void done(const Unit&) const {}
};

__device__ __forceinline__ unsigned cvt_pk_bf16(float lo, float hi) { unsigned r; asm volatile("v_cvt_pk_bf16_f32 %0, %1, %2" : "=v"(r) : "v"(lo), "v"(hi)); return r; }
typedef unsigned u32x2 __attribute__((ext_vector_type(2)));
#ifndef RESID_BF16
#define RESID_BF16 1
#endif
constexpr float EPSN = 1e-6f;
#define PG8_GAS __attribute__((address_space(1)))
#ifndef EPI_RS_BATCH
#define EPI_RS_BATCH 1
#endif
#ifndef EPI_PBN
#define EPI_PBN 1
#endif
#ifndef EPI_PB_BATCH
#define EPI_PB_BATCH 1
#endif
__device__ __forceinline__ float rsq_(float v) { return __builtin_amdgcn_rsqf(v); }
__device__ __forceinline__ float sigm_(float v) { return __builtin_amdgcn_rcpf(1.0f + __builtin_amdgcn_exp2f(-1.4426950408889634f * v)); }
__device__ __forceinline__ float xsum16_32(float v) {
    { auto r = __builtin_amdgcn_permlane16_swap(__float_as_uint(v), __float_as_uint(v), false, false); v = __uint_as_float(r[0]) + __uint_as_float(r[1]); }
    { auto r = __builtin_amdgcn_permlane32_swap(__float_as_uint(v), __float_as_uint(v), false, false); v = __uint_as_float(r[0]) + __uint_as_float(r[1]); }
    return v;
}
__device__ __forceinline__ float row_rstd(const float* ssq, int row) {
    const f32x4 s = *(const PG8_GAS f32x4*)(ssq + (size_t)row * 4);
    return rsq_(((s[0] + s[1]) + (s[2] + s[3])) * (1.0f / 1024.0f) + EPSN);
}
struct EpiP { int kind; int ldo; bf16_t* O; bf16_t* Kd; bf16_t* Vd; const float* ssq_in; const float* bias; const float* qg; const float* kg; const float* rope;
    const float* base; float* out; bf16_t* xb; bf16_t* xbw; float* ssq_out; float alpha; float qscale; };
struct EpiAny {
    static constexpr bool PERM = true, AFTER_DRAIN = false;
    const PG8_LAS EpiP* P; PG8_LAS float* xl;
    __device__ __forceinline__ void operator()(const f32x4 (&acc)[2][2][4][2], const Unit& u, int wr, int wc, int fr, int fq) const {
        const int kind = __builtin_amdgcn_readfirstlane(P->kind);
        const float* ssq_in = P->ssq_in; const float* bias = P->bias;
        const int rowt = u.pm * BM + wr * 64 + fr;
        if (kind <= 1) {
            const int colo = u.pn * 128 + wc * 32 + 8 * fq; bf16_t* O = P->O; const int ldo = P->ldo;
            f32x4 bv0[2], bv1[2];
#pragma unroll
            for (int n = 0; n < 2; ++n) { bv0[n] = (f32x4){0.f, 0.f, 0.f, 0.f}; bv1[n] = bv0[n]; }
            if (kind == 1) {
#pragma unroll
                for (int n = 0; n < 2; ++n) { bv0[n] = *(const PG8_GAS f32x4*)(bias + colo + 4 * n); bv1[n] = *(const PG8_GAS f32x4*)(bias + 1024 + colo + 4 * n); }
            }
#pragma unroll
            for (int ai = 0; ai < 2; ++ai) {
                float rs4[4];
#pragma unroll
                for (int m = 0; m < 4; ++m) rs4[m] = EPI_RS_BATCH ? row_rstd(ssq_in, rowt + ai * HALF + m * 16) : 0.f;
#pragma unroll
                for (int m = 0; m < 4; ++m) {
                    const int row = rowt + ai * HALF + m * 16; const float rs = EPI_RS_BATCH ? rs4[m] : row_rstd(ssq_in, row);
                    u32x4 w;
#pragma unroll
                    for (int n = 0; n < 2; ++n) {
                        const f32x4 a0 = acc[ai][0][m][n] * rs + bv0[n], a1 = acc[ai][1][m][n] * rs + bv1[n]; f32x4 r;
                        if (kind == 0) {
#pragma unroll
                            for (int j = 0; j < 4; ++j) r[j] = a0[j] * sigm_(a0[j]) * a1[j];
                        } else {
#pragma unroll
                            for (int j = 0; j < 4; ++j) r[j] = a0[j] * sigm_(a1[j]);
                        }
                        w[2 * n] = cvt_pk_bf16(r[0], r[1]); w[2 * n + 1] = cvt_pk_bf16(r[2], r[3]);
                    }
                    *(PG8_GAS u32x4*)(O + (size_t)row * ldo + colo) = w;
                }
            }
        } else if (kind <= 3) {
            const int sect = u.pn >> 2, pnl = u.pn & 3;
            bf16_t* dst = sect == 0 ? P->O : (sect == 1 ? P->Kd : P->Vd); const float* qg = P->qg; const float* kg = P->kg; const float* rope = P->rope; const float qscale = P->qscale;
            const int colb = pnl * 256 + wc * 64 + 8 * fq;
            f32x4 gv[2][2];
#pragma unroll
            for (int bj = 0; bj < 2; ++bj)
#pragma unroll
                for (int n = 0; n < 2; ++n) gv[bj][n] = (f32x4){1.f, 1.f, 1.f, 1.f};
            if (sect < 2) { const float* g = sect == 0 ? qg : kg; const float sc = sect == 0 ? qscale : 1.0f;
#pragma unroll
                for (int bj = 0; bj < 2; ++bj)
#pragma unroll
                    for (int n = 0; n < 2; ++n) gv[bj][n] = *(const PG8_GAS f32x4*)(g + 32 * bj + 8 * fq + 4 * n) * sc; }
#pragma unroll
            for (int ai = 0; ai < 2; ++ai) {
                float rs4[4];
#pragma unroll
                for (int m = 0; m < 4; ++m) rs4[m] = EPI_RS_BATCH ? row_rstd(ssq_in, rowt + ai * HALF + m * 16) : 0.f;
#pragma unroll
                for (int m = 0; m < 4; ++m) {
                    const int row = rowt + ai * HALF + m * 16; const float rs = EPI_RS_BATCH ? rs4[m] : row_rstd(ssq_in, row);
                    f32x4 v[2][2];
#pragma unroll
                    for (int bj = 0; bj < 2; ++bj)
#pragma unroll
                        for (int n = 0; n < 2; ++n) v[bj][n] = acc[ai][bj][m][n] * rs;
                    if (sect < 2) {
                        float s = 0.f;
#pragma unroll
                        for (int bj = 0; bj < 2; ++bj)
#pragma unroll
                            for (int n = 0; n < 2; ++n) { const f32x4 t = v[bj][n]; s += (t[0] * t[0] + t[1] * t[1]) + (t[2] * t[2] + t[3] * t[3]); }
                        s = xsum16_32(s);
                        const float r = rsq_(s * (1.0f / 64.0f) + EPSN);
#pragma unroll
                        for (int bj = 0; bj < 2; ++bj)
#pragma unroll
                            for (int n = 0; n < 2; ++n) v[bj][n] = v[bj][n] * r * gv[bj][n];
                        if (kind == 3) {
                            const PG8_GAS f32x4* rp = (const PG8_GAS f32x4*)(rope + (size_t)row * 16);
#pragma unroll
                            for (int n = 0; n < 2; ++n) {
                                const f32x4 cs = rp[n], sn = rp[2 + n]; const f32x4 own = v[0][n]; f32x4 oth;
#pragma unroll
                                for (int j = 0; j < 4; ++j) oth[j] = __shfl_xor(own[j], 16);
                                const f32x4 rr = (fq == 0) ? (own * cs - oth * sn) : (own * cs + oth * sn);
                                if (fq < 2) v[0][n] = rr;
                            }
                        }
                    }
#pragma unroll
                    for (int bj = 0; bj < 2; ++bj) {
                        u32x4 w; w[0] = cvt_pk_bf16(v[bj][0][0], v[bj][0][1]); w[1] = cvt_pk_bf16(v[bj][0][2], v[bj][0][3]); w[2] = cvt_pk_bf16(v[bj][1][0], v[bj][1][1]); w[3] = cvt_pk_bf16(v[bj][1][2], v[bj][1][3]);
                        *(PG8_GAS u32x4*)(dst + (size_t)row * 1024 + colb + 32 * bj) = w;
                    }
                }
            }
        } else if (kind == 9) {
            if (u.pm < 0) *(PG8_GAS float*)(P->ssq_out) = acc[0][0][0][0][0] + acc[1][1][3][1][3];
        } else {
            const int col0 = u.pn * BM + wc * 32 + 8 * fq; float* out = P->out; bf16_t* xb = P->xb; bf16_t* xbw = P->xbw; float* ssq_out = P->ssq_out; const float alpha = P->alpha;
            f32x4 bv[2][2];
#pragma unroll
            for (int bj = 0; bj < 2; ++bj)
#pragma unroll
                for (int n = 0; n < 2; ++n) bv[bj][n] = bias ? *(const PG8_GAS f32x4*)(bias + col0 + bj * HALF + n * 4) : (f32x4){0.f, 0.f, 0.f, 0.f};
#pragma unroll
            for (int am = 0; am < 4; ++am) {
                u32x4 pb[2][2];
#pragma unroll
                for (int mm = 0; mm < 2; ++mm)
#pragma unroll
                    for (int bj = 0; bj < 2; ++bj) pb[mm][bj] = *(const PG8_GAS u32x4*)(xb + (size_t)(rowt + (am >> 1) * HALF + ((am & 1) * 2 + mm) * 16) * 1024 + col0 + bj * HALF);
#pragma unroll
                for (int mm = 0; mm < 2; ++mm) { const int ai = am >> 1, m = (am & 1) * 2 + mm;
                    const int row = rowt + ai * HALF + m * 16; const size_t off = (size_t)row * 1024 + col0; float s = 0.f;
#pragma unroll
                    for (int bj = 0; bj < 2; ++bj) {
                        const u32x4 bb = pb[mm][bj]; u32x4 w;
#pragma unroll
                        for (int n = 0; n < 2; ++n) {
                            const f32x4 b = {__uint_as_float(bb[2 * n] << 16), __uint_as_float(bb[2 * n] & 0xffff0000u), __uint_as_float(bb[2 * n + 1] << 16), __uint_as_float(bb[2 * n + 1] & 0xffff0000u)};
                            const f32x4 t = b + (acc[ai][bj][m][n] + bv[bj][n]) * alpha;
                            if (out) *(PG8_GAS f32x4*)(out + off + bj * HALF + n * 4) = t;
                            w[2 * n] = cvt_pk_bf16(t[0], t[1]); w[2 * n + 1] = cvt_pk_bf16(t[2], t[3]);
                            s += (t[0] * t[0] + t[1] * t[1]) + (t[2] * t[2] + t[3] * t[3]);
                        }
                        *(PG8_GAS u32x4*)(xbw + off + bj * HALF) = w;
                    }
                    s = xsum16_32(s);
                    if (fq == 0) xl[(ai * HALF + wr * 64 + m * 16 + fr) * 4 + wc] = s;
                }
            }
            asm volatile("s_waitcnt lgkmcnt(0)" ::: "memory"); __builtin_amdgcn_s_barrier(); asm volatile("" ::: "memory");
            if (wc == 0) {
#pragma unroll
                for (int ai = 0; ai < 2; ++ai) { const int rl = ai * HALF + wr * 64 + fq * 16 + fr; const f32x4 t = *(const PG8_LAS f32x4*)(xl + rl * 4);
                    *(PG8_GAS float*)(ssq_out + (size_t)(u.pm * BM + rl) * 4 + u.pn) = (t[0] + t[1]) + (t[2] + t[3]); }
            }
        }
    }
};
template <class Epi, class Sched, bool ALIGN_EPI = false, bool SP2 = false>
__device__ __forceinline__ void gemm_phase(PG8_LAS unsigned char* lds, const Gemm g, const Sched& S, const Epi& E) {
    const int tid = otid(), wid = __builtin_amdgcn_readfirstlane(tid >> 6), lane = tid & 63, wr = wid >> 2, wc = wid & 3, fr = lane & 15, fq = lane >> 4;
    const int K = g.K, nt = K / BK;
    unsigned voffA[2], voffB[2];
#pragma unroll
    for (int i = 0; i < 2; ++i) { int R, C; stage_rc(tid * 16 + i * 8192, R, C); const int Rb = Epi::PERM ? ((R & ~31) + perm32(R & 31)) : R;
        voffA[i] = (unsigned)(R * K + C) * 2u; voffB[i] = (unsigned)(Rb * K + C) * 2u; }
    const size_t kstep = (size_t)(BK * 2);
    const size_t hstep = (size_t)HALF * K * 2;
    const size_t tstep = 2 * hstep;
    const unsigned ldsw = (unsigned)wid * 1024u;
    const int aoff = lds_byte(wr * 64 + fr, fq * 8), boff = lds_byte(wc * 32 + fr, fq * 8);
#define PG8_SA(b, h) (((b) * 2 + (h)) * HTB)
#define PG8_SB(b, h) ((4 + (b) * 2 + (h)) * HTB)
#define PG8_STAGE(bufoff, gbase, voff) do { _Pragma("unroll") for (int _i = 0; _i < 2; ++_i) \
        __builtin_amdgcn_global_load_lds((const unsigned*)((const char*)(gbase) + (voff)[_i]), (PG8_LAS unsigned*)(lds + (bufoff) + ldsw + _i * 8192), 16, 0, 0); } while (0)
#define PG8_LDA(dst, b, h) do { _Pragma("unroll") for (int m = 0; m < 4; ++m) _Pragma("unroll") for (int k = 0; k < 2; ++k) dst[m][k] = *(const PG8_LAS bf16x8*)(lds + PG8_SA(b, h) + aoff + m * 2048 + k * 1024); } while (0)
#define PG8_LDB(dst, b, h) do { _Pragma("unroll") for (int n = 0; n < 2; ++n) _Pragma("unroll") for (int k = 0; k < 2; ++k) dst[n][k] = *(const PG8_LAS bf16x8*)(lds + PG8_SB(b, h) + boff + n * 2048 + k * 1024); } while (0)
#define PG8_MMA(ai, bj, At, Bt) do { __builtin_amdgcn_s_setprio(1); _Pragma("unroll") for (int m = 0; m < 4; ++m) _Pragma("unroll") for (int n = 0; n < 2; ++n) _Pragma("unroll") for (int k = 0; k < 2; ++k) \
        acc[ai][bj][m][n] = __builtin_amdgcn_mfma_f32_16x16x32_bf16(Bt[n][k], At[m][k], acc[ai][bj][m][n], 0, 0, 0); __builtin_amdgcn_s_setprio(0); } while (0)
#define PG8_WAIT_V(n) asm volatile("s_waitcnt vmcnt(" #n ")" ::: "memory")
#define PG8_WAIT_L(n) asm volatile("s_waitcnt lgkmcnt(" #n ")" ::: "memory")
#define PG8_BAR __builtin_amdgcn_s_barrier()
#define PG8_SCHED __builtin_amdgcn_sched_barrier(0)
    Unit cur, nxt; int ui = 0;
    if (!S.next(0, cur)) return;
    f32x4 acc[2][2][4][2];
#pragma unroll
    for (int a = 0; a < 2; ++a)
#pragma unroll
        for (int b = 0; b < 2; ++b)
#pragma unroll
            for (int m = 0; m < 4; ++m)
#pragma unroll
                for (int n = 0; n < 2; ++n) acc[a][b][m][n] = (f32x4){0.f, 0.f, 0.f, 0.f};
    bf16x8 At[4][2], B0[2][2], B1[2][2];
    const char* cA = (const char*)g.A + (size_t)cur.pm * tstep; const char* cB = (const char*)g.Bt + (size_t)cur.pn * tstep;
    S.a_ready(cur);
    if constexpr (SP2) {
        PG8_STAGE(PG8_SB(0, 0), cB, voffB); PG8_STAGE(PG8_SB(0, 1), cB + hstep, voffB); PG8_STAGE(PG8_SA(0, 0), cA, voffA); PG8_STAGE(PG8_SA(0, 1), cA + hstep, voffA);
        if (wr == 1) PG8_BAR;
        PG8_WAIT_V(2); PG8_BAR;
        PG8_STAGE(PG8_SB(1, 0), cB + kstep, voffB); PG8_STAGE(PG8_SA(1, 0), cA + kstep, voffA); PG8_STAGE(PG8_SB(1, 1), cB + hstep + kstep, voffB);
        PG8_WAIT_V(6); PG8_BAR;
    } else {
        PG8_STAGE(PG8_SB(0, 0), cB, voffB); PG8_STAGE(PG8_SA(0, 0), cA, voffA); PG8_STAGE(PG8_SB(0, 1), cB + hstep, voffB); PG8_STAGE(PG8_SA(0, 1), cA + hstep, voffA);
        if (wr == 1) PG8_BAR;
        PG8_WAIT_V(4); PG8_BAR;
        PG8_STAGE(PG8_SB(1, 0), cB + kstep, voffB); PG8_STAGE(PG8_SA(1, 0), cA + kstep, voffA); PG8_STAGE(PG8_SB(1, 1), cB + hstep + kstep, voffB);
        PG8_WAIT_V(6); PG8_BAR;
    }
    for (;;) {
        const bool has_next = S.next(ui + 1, nxt);
        const char* nA = has_next ? (const char*)g.A + (size_t)nxt.pm * tstep : cA; const char* nB = has_next ? (const char*)g.Bt + (size_t)nxt.pn * tstep : cB;
        for (int t = 0; t < nt; t += 2) {
            const bool last = (t == nt - 2);
            const char* a1 = cA + (size_t)(t + 1) * kstep;
            const char* a2 = last ? nA : cA + (size_t)(t + 2) * kstep; const char* b2 = last ? nB : cB + (size_t)(t + 2) * kstep;
            const char* a3 = a2 + kstep; const char* b3 = b2 + kstep;
            if (last && has_next) S.a_ready(nxt);
            if constexpr (SP2) {
            PG8_LDB(B0, 0, 0); PG8_LDB(B1, 0, 1); PG8_SCHED; PG8_LDA(At, 0, 0); PG8_STAGE(PG8_SA(1, 1), a1 + hstep, voffA);
            PG8_WAIT_V(8); PG8_WAIT_L(0); PG8_BAR; PG8_MMA(0, 0, At, B0); PG8_MMA(0, 1, At, B1); PG8_BAR; PG8_SCHED;
            PG8_LDA(At, 0, 1); PG8_STAGE(PG8_SB(0, 0), b2, voffB); PG8_STAGE(PG8_SB(0, 1), b2 + hstep, voffB); PG8_STAGE(PG8_SA(0, 0), a2, voffA);
            PG8_WAIT_V(8); PG8_WAIT_L(0); PG8_BAR; PG8_MMA(1, 0, At, B0); PG8_MMA(1, 1, At, B1); PG8_BAR; PG8_SCHED;
            PG8_LDB(B0, 1, 0); PG8_LDB(B1, 1, 1); PG8_SCHED; PG8_LDA(At, 1, 0); PG8_STAGE(PG8_SA(0, 1), a2 + hstep, voffA);
            PG8_WAIT_V(8); PG8_WAIT_L(0); PG8_BAR; PG8_MMA(0, 0, At, B0); PG8_MMA(0, 1, At, B1); PG8_BAR; PG8_SCHED;
            PG8_LDA(At, 1, 1); PG8_STAGE(PG8_SB(1, 0), b3, voffB); PG8_STAGE(PG8_SB(1, 1), b3 + hstep, voffB); PG8_STAGE(PG8_SA(1, 0), a3, voffA);
            PG8_WAIT_V(8); PG8_WAIT_L(0); PG8_BAR; PG8_MMA(1, 0, At, B0); PG8_MMA(1, 1, At, B1); PG8_BAR; PG8_SCHED;
            } else {
            PG8_LDB(B0, 0, 0); PG8_SCHED; PG8_LDA(At, 0, 0); PG8_STAGE(PG8_SA(1, 1), a1 + hstep, voffA);
            PG8_WAIT_L(8); PG8_BAR; PG8_WAIT_L(0); PG8_MMA(0, 0, At, B0); PG8_BAR; PG8_SCHED;
            PG8_LDB(B1, 0, 1); PG8_STAGE(PG8_SB(0, 0), b2, voffB);
            PG8_BAR; PG8_WAIT_L(0); PG8_MMA(0, 1, At, B1); PG8_BAR;
            PG8_LDA(At, 0, 1); PG8_STAGE(PG8_SA(0, 0), a2, voffA);
            PG8_BAR; PG8_WAIT_L(0); PG8_MMA(1, 0, At, B0); PG8_BAR; PG8_SCHED;
            PG8_STAGE(PG8_SB(0, 1), b2 + hstep, voffB);
            PG8_WAIT_V(6); PG8_BAR; PG8_MMA(1, 1, At, B1); PG8_BAR;
            PG8_LDB(B0, 1, 0); PG8_SCHED; PG8_LDA(At, 1, 0); PG8_STAGE(PG8_SA(0, 1), a2 + hstep, voffA);
            PG8_WAIT_L(8); PG8_BAR; PG8_WAIT_L(0); PG8_MMA(0, 0, At, B0); PG8_BAR; PG8_SCHED;
            PG8_LDB(B1, 1, 1); PG8_STAGE(PG8_SB(1, 0), b3, voffB);
            PG8_BAR; PG8_WAIT_L(0); PG8_MMA(0, 1, At, B1); PG8_BAR;
            PG8_LDA(At, 1, 1); PG8_STAGE(PG8_SA(1, 0), a3, voffA);
            PG8_BAR; PG8_WAIT_L(0); PG8_MMA(1, 0, At, B0); PG8_BAR; PG8_SCHED;
            PG8_STAGE(PG8_SB(1, 1), b3 + hstep, voffB);
            PG8_WAIT_V(6); PG8_BAR; PG8_MMA(1, 1, At, B1); PG8_BAR;
            }
        }
        if constexpr (ALIGN_EPI) { if (wr == 0) PG8_BAR; }
        if constexpr (!Epi::AFTER_DRAIN) { E(acc, cur, wr, wc, fr, fq); S.done(cur); }
        if (!has_next) break;
#pragma unroll
        for (int a = 0; a < 2; ++a)
#pragma unroll
            for (int b = 0; b < 2; ++b)
#pragma unroll
                for (int m = 0; m < 4; ++m)
#pragma unroll
                    for (int n = 0; n < 2; ++n) acc[a][b][m][n] = (f32x4){0.f, 0.f, 0.f, 0.f};
        cur = nxt; cA = nA; cB = nB; ++ui;
        if constexpr (ALIGN_EPI) { if (wr == 1) PG8_BAR; }
    }
    PG8_WAIT_V(0);
    if constexpr (!ALIGN_EPI) { if (wr == 0) PG8_BAR; }
    PG8_BAR;
    if constexpr (Epi::AFTER_DRAIN) { E.fused(acc, cur, wr, wc, fr, fq, lds, wid, lane); S.done(cur); }
#undef PG8_SA
#undef PG8_SB
#undef PG8_STAGE
#undef PG8_LDA
#undef PG8_LDB
#undef PG8_MMA
#undef PG8_WAIT_V
#undef PG8_WAIT_L
#undef PG8_BAR
#undef PG8_SCHED
}
}

#include <hip/hip_bf16.h>
#include <cmath>
namespace attn_body {
using bf16=__hip_bfloat16;
using bf16x8=__attribute__((ext_vector_type(8)))short;
using s16x4=__attribute__((ext_vector_type(4)))short;
using f32x16=__attribute__((ext_vector_type(16)))float;
using u32x4=__attribute__((ext_vector_type(4)))unsigned;
constexpr int BATCH=8,NHEAD=16,SEQ=4096,D=64,DM=NHEAD*D;
constexpr int NW=8,QBLK=32,QB=QBLK*NW,KVBLK=64,NQB=SEQ/QB;
constexpr int ATTN_PITCH=DM, ATTN_UNIT_ROWS=QB;
__device__ __forceinline__ int crow(int r,int hi){return (r&3)+8*(r>>2)+4*hi;}
#define SBAR() __builtin_amdgcn_sched_barrier(0)
__device__ __forceinline__ void cmask(f32x16&p0,f32x16&p1,int jb,int qrel,int hi){
  const float NEG=-INFINITY; int kb=64*jb+4*hi;
  #pragma unroll
  for(int r=0;r<16;++r){int kv=kb+(r&3)+8*(r>>2); if(kv>qrel)p0[r]=NEG; if(kv+32>qrel)p1[r]=NEG;}
}

template<int MODE> __device__ __forceinline__ void cmask_t(f32x16&p0,f32x16&p1,int jb,int qrel,int hi,int wid){
  if(MODE!=1){cmask(p0,p1,jb,qrel,hi);} else { if(jb>(wid>>1)){ const float NEG=-INFINITY;
    #pragma unroll
    for(int r=0;r<16;++r){p0[r]=NEG;p1[r]=NEG;} } } }
typedef float f32x4_t __attribute__((ext_vector_type(4)));
constexpr int NSLOT=3, SLOTB=8192;
constexpr int LDS_K=0, LDS_V=NSLOT*SLOTB, LDS_WS=2*NSLOT*SLOTB, LDS_OST=LDS_WS+NW*64*4, LDS_BYTES=LDS_OST+NW*4096, LDS_X=LDS_BYTES, LDS_TOTAL=LDS_X+32768;
constexpr float C2=0.125f*1.4426950408889634f;
__device__ __forceinline__ void glds16(const void*gsrc,unsigned lds_dst){unsigned keep;
  asm volatile("s_mov_b32 %0, m0\n\ts_mov_b32 m0, %2\n\ts_nop 0\n\tglobal_load_lds_dwordx4 %1, off\n\ts_mov_b32 m0, %0":"=&s"(keep):"v"(gsrc),"s"(lds_dst):"memory");}
__device__ __forceinline__ float max3f(float a,float b,float c){float r;asm("v_max3_f32 %0, %1, %2, %3":"=v"(r):"v"(a),"v"(b),"v"(c));return r;}
__device__ __forceinline__ float max2f(float a,float b){float r;asm("v_max_f32_e32 %0, %1, %2":"=v"(r):"v"(a),"v"(b));return r;}
__device__ __forceinline__ float fadd_s(float a,float b){float r;asm("v_add_f32_e32 %0, %1, %2":"=v"(r):"v"(a),"v"(b));return r;}
__device__ __forceinline__ float fsub_s(float a,float b){float r;asm("v_sub_f32_e32 %0, %1, %2":"=v"(r):"v"(a),"v"(b));return r;}
typedef float f32x2_t __attribute__((ext_vector_type(2))); typedef __bf16 bf16x2_t __attribute__((ext_vector_type(2)));
__device__ __forceinline__ unsigned cvtpk_s(float lo,float hi){f32x2_t v={lo,hi};bf16x2_t b=__builtin_convertvector(v,bf16x2_t);return __builtin_bit_cast(unsigned,b);}
#define WAIT_BAR(N) asm volatile("s_waitcnt vmcnt(" #N ") lgkmcnt(0)\n\ts_barrier":::"memory")

__device__ __forceinline__ void qkt(f32x16&p0,f32x16&p1,const char*Kslot,const bf16x8*qr,const f32x16&negm,int r32,int hi){
  const char*kb=Kslot+hi*1024+r32*16;
  #pragma unroll
  for(int d0=0;d0<4;++d0){
    const bf16x8 b0=*reinterpret_cast<const bf16x8*>(kb+d0*2048);
    const bf16x8 b1=*reinterpret_cast<const bf16x8*>(kb+d0*2048+512);
    if(d0==0){p0=__builtin_amdgcn_mfma_f32_32x32x16_bf16(b0,qr[0],negm,0,0,0);p1=__builtin_amdgcn_mfma_f32_32x32x16_bf16(b1,qr[0],negm,0,0,0);}
    else{p0=__builtin_amdgcn_mfma_f32_32x32x16_bf16(b0,qr[d0],p0,0,0,0);p1=__builtin_amdgcn_mfma_f32_32x32x16_bf16(b1,qr[d0],p1,0,0,0);}}
}
typedef __attribute__((address_space(3))) const char* lds_cptr;
typedef short v4i16_t __attribute__((ext_vector_type(4)));
__device__ __forceinline__ void kload8(bf16x8*kf,lds_cptr kp){
  kf[0]=*(const __attribute__((address_space(3))) bf16x8*)(kp);      kf[1]=*(const __attribute__((address_space(3))) bf16x8*)(kp+512);
  kf[2]=*(const __attribute__((address_space(3))) bf16x8*)(kp+2048); kf[3]=*(const __attribute__((address_space(3))) bf16x8*)(kp+2560);
  kf[4]=*(const __attribute__((address_space(3))) bf16x8*)(kp+4096); kf[5]=*(const __attribute__((address_space(3))) bf16x8*)(kp+4608);
  kf[6]=*(const __attribute__((address_space(3))) bf16x8*)(kp+6144); kf[7]=*(const __attribute__((address_space(3))) bf16x8*)(kp+6656);
}
__device__ __forceinline__ void kload2(bf16x8*kf,lds_cptr kp,int j){ kf[2*j]=*(const __attribute__((address_space(3))) bf16x8*)(kp+j*2048); kf[2*j+1]=*(const __attribute__((address_space(3))) bf16x8*)(kp+j*2048+512); }
__device__ __forceinline__ s16x4 vtr(lds_cptr p){ return __builtin_bit_cast(s16x4,__builtin_amdgcn_ds_read_tr16_b64_v4i16((__attribute__((address_space(3))) v4i16_t*)p)); }
__device__ __forceinline__ float rowmax(const f32x16&p0,const f32x16&p1){
  float a=max3f(p0[0],p0[1],p1[0]),b=max3f(p0[2],p0[3],p1[1]);a=max3f(a,p1[2],p1[3]);
  #pragma unroll
  for(int r=4;r<16;r+=4){a=max3f(a,p0[r],p0[r+1]);b=max3f(b,p0[r+2],p0[r+3]);a=max3f(a,p1[r],p1[r+1]);b=max3f(b,p1[r+2],p1[r+3]);}
  const float m=max2f(a,b);
  auto rr=__builtin_amdgcn_permlane32_swap(__float_as_uint(m),__float_as_uint(m),false,false);
  return max2f(__uint_as_float(rr[0]),__uint_as_float(rr[1]));
}
__device__ __forceinline__ void pv(f32x16*o,int vb,bf16x8 pa0,bf16x8 pa1,bf16x8 pa2,bf16x8 pa3){
  #pragma unroll
  for(int d0=0;d0<2;++d0){s16x4 lo[4],hi[4];
    #pragma unroll
    for(int ks=0;ks<4;++ks){
      asm volatile("ds_read_b64_tr_b16 %0,%1 offset:%c2":"=&v"(lo[ks]):"v"(vb),"i"(d0*4096+ks*1024):"memory");
      asm volatile("ds_read_b64_tr_b16 %0,%1 offset:%c2":"=&v"(hi[ks]):"v"(vb),"i"(d0*4096+ks*1024+512):"memory");}
    asm volatile("s_waitcnt lgkmcnt(0)":::"memory");SBAR();
    #define PK(k) (bf16x8){lo[k][0],lo[k][1],lo[k][2],lo[k][3],hi[k][0],hi[k][1],hi[k][2],hi[k][3]}
    o[d0]=__builtin_amdgcn_mfma_f32_32x32x16_bf16(pa0,PK(0),o[d0],0,0,0);
    o[d0]=__builtin_amdgcn_mfma_f32_32x32x16_bf16(pa1,PK(1),o[d0],0,0,0);
    o[d0]=__builtin_amdgcn_mfma_f32_32x32x16_bf16(pa2,PK(2),o[d0],0,0,0);
    o[d0]=__builtin_amdgcn_mfma_f32_32x32x16_bf16(pa3,PK(3),o[d0],0,0,0);
    #undef PK
  }
}

#ifndef ATTN_STORE16
#define ATTN_STORE16(p,v) (*(u32x4*)(p)=(v))
#endif
template<int THRL,int MODE,int EPI> __device__ __forceinline__ void attn_unit(int b,int hq,int hv,int ho,int qb,const bf16*Q,const bf16*__restrict__ K,const bf16*__restrict__ V,bf16*O,char*shm,float lam,int t0=0){
  const int tid=otid(),lane=tid&63,r32=lane&31,hi=lane>>5; const int wid=__builtin_amdgcn_readfirstlane(tid>>6);
  const long rowbase=(long)b*SEQ; const int q0=qb*QB;
  const bf16*Qw=Q+(rowbase+q0+wid*QBLK)*DM+hq*D;
  const bf16*Kh=K+(rowbase+(long)t0*KVBLK)*DM+hq*D,*Vh=V+(rowbase+(long)t0*KVBLK)*DM+hv*D;
  const float*nbl=(const float*)(shm+LDS_X)+t0*KVBLK;
  const unsigned lds0=(unsigned)(uintptr_t)shm;
  float*wsf=(float*)(shm+LDS_WS)+wid*64;
  const bf16*ksrc=Kh+(long)lane*DM+wid*8;
  const bf16*vsrc=Vh+(long)(16*(wid&3)+(lane>>2))*DM+(wid>>2)*32+(lane&3)*8;
  const unsigned kdst=lds0+LDS_K+wid*1024, vdst=lds0+LDS_V+wid*1024;
  #define DMA_K(t,slot) glds16(ksrc+(long)(t)*KVBLK*DM,(unsigned)__builtin_amdgcn_readfirstlane(kdst+(slot)))
  #define DMA_V(t,slot) glds16(vsrc+(long)(t)*KVBLK*DM,(unsigned)__builtin_amdgcn_readfirstlane(vdst+(slot)))
  const int vb0=(int)(lds0+LDS_V)+((lane>>4)&1)*32+(lane&3)*8+(4*hi+((lane&15)>>2))*64;
  const char*Kbase=shm+LDS_K; bf16x8 kf[8];
  const lds_cptr shm3=(lds_cptr)shm; const lds_cptr kp0=shm3+LDS_K+hi*1024+r32*16; const lds_cptr vp0=shm3+LDS_V+((lane>>4)&1)*32+(lane&3)*8+(4*hi+((lane&15)>>2))*64;
  const int NT=(q0+QB)/KVBLK-t0;
  DMA_K(0,0);DMA_V(0,0);DMA_K(1,SLOTB);
  bf16x8 qr[4];
  #pragma unroll
  for(int d0=0;d0<4;++d0)qr[d0]=*reinterpret_cast<const bf16x8*>(&Qw[(long)r32*DM+d0*16+hi*8]);
  float mhat=0.f,l_reg=0.f;f32x16 o[2];o[0]=f32x16{};o[1]=f32x16{};f32x16 negm=f32x16{};asm volatile("":"+v"(negm)); const f32x16 zero16=f32x16{};
  #define CIN (MODE==0?zero16:negm)
  const int qrel=wid*QBLK+r32;
  #define ADDB(P0,P1,t) do{ if(MODE==0){ const float*nbp_=nbl+64*(t)+4*hi; _Pragma("unroll") for(int g_=0;g_<4;++g_){ const f32x4_t b0_=*(const f32x4_t*)(nbp_+8*g_); const f32x4_t b1_=*(const f32x4_t*)(nbp_+32+8*g_); _Pragma("unroll") for(int j_=0;j_<4;++j_){P0[4*g_+j_]+=(b0_[j_]-mhat);P1[4*g_+j_]+=(b1_[j_]-mhat);} } } }while(0)
  #define CMASK(P0,P1,t) do{int jb_=(t)-(NT-4); if(jb_>=0)cmask_t<MODE>(P0,P1,jb_,qrel,hi,wid);}while(0)
  bool resc=false;
  #define START(P0,P1) do{ const float rm=rowmax(P0,P1); resc=false; \
    { const float dl=rm; mhat=fadd_s(mhat,dl); \
      _Pragma("unroll") for(int r=0;r<16;++r){P0[r]=fsub_s(P0[r],dl);P1[r]=fsub_s(P1[r],dl);} \
      _Pragma("unroll") for(int r=0;r<16;++r)negm[r]=-mhat; asm volatile("":"+v"(negm)); } \
    _Pragma("unroll") for(int r=0;r<16;++r)P0[r]=__builtin_amdgcn_exp2f(P0[r]); }while(0)
  #define RESC() do{ if(resc){ asm volatile("s_waitcnt lgkmcnt(0)":::"memory"); \
      _Pragma("unroll") for(int d_=0;d_<2;++d_) _Pragma("unroll") for(int r=0;r<16;++r)o[d_][r]*=wsf[crow(r,hi)]; } }while(0)
  f32x16 pA0,pA1,pB0,pB1;
  int sl_prev=0,sl_cur=0,sl_next=SLOTB;
  #define ROT() do{sl_prev=sl_cur;sl_cur=sl_next;sl_next=(sl_next==(NSLOT-1)*SLOTB)?0:sl_next+SLOTB;}while(0)
  DMA_K(2,2*SLOTB);
  WAIT_BAR(3);
  qkt(pA0,pA1,Kbase,qr,CIN,r32,hi);asm volatile("s_nop 15\n\ts_nop 7":"+v"(pA0),"+v"(pA1));ADDB(pA0,pA1,0);CMASK(pA0,pA1,0);
  START(pA0,pA1);
  _Pragma("unroll") for(int r=0;r<16;++r)pA1[r]=__builtin_amdgcn_exp2f(pA1[r]);
  WAIT_BAR(0);
  DMA_K(3,0);DMA_V(1,SLOTB);
  ROT();
  kload8(kf,kp0+sl_cur);
  WAIT_BAR(2);
  s16x4 vlo[8],vhi[8]; u32x4 pw0,pw1,pw2,pw3;
  #define PKW(P,B) cvtpk_s(P[B],P[B+1])
  #define PAF(k) __builtin_bit_cast(bf16x8,pw##k)
  #define VFR(i) (bf16x8){vlo[i][0],vlo[i][1],vlo[i][2],vlo[i][3],vhi[i][0],vhi[i][1],vhi[i][2],vhi[i][3]}
  #define PIN(x) asm volatile("":"+v"(x))
  #define MX3(a,b,c) __builtin_fmaxf(__builtin_fmaxf((a),(b)),(c))
  #define GAPA(MF,A0,A1,A2,A3,W0,W1,PW) do{ MF; sacc+=A0; sacc+=A1; sacc+=A2; sacc+=A3; PIN(sacc); W0; W1; PIN(PW); SBAR(); }while(0)
  #define EX(v) __builtin_amdgcn_exp2f(v)
  #define GAPB(MF,X,B) do{ MF; X[B]=EX(X[B]); X[B+1]=EX(X[B+1]); X[B+2]=EX(X[B+2]); X[B+3]=EX(X[B+3]); PIN(X); SBAR(); }while(0)
  #define VRD(i) do{ vlo[i]=vtr(vp_+(((i)>>2)*4096+((i)&3)*1024)); vhi[i]=vtr(vp_+(((i)>>2)*4096+((i)&3)*1024+512)); }while(0)
  #define KRD(G,j) do{ if(G){ kload2(kf,kp0+sl_next,j); SBAR(); } }while(0)
  #define STEP(C0,C1,P0,P1,t,GK,GV,GL) do{ SBAR(); \
    const lds_cptr vp_=vp0+sl_prev; \
    VRD(0); SBAR(); float sacc=(P0[0]+P0[1]); \
    GAPA(C0=__builtin_amdgcn_mfma_f32_32x32x16_bf16(kf[0],qr[0],CIN,0,0,0), P0[2],P0[3],P0[4],P0[5],     pw0[0]=PKW(P0,0), pw0[1]=PKW(P0,2), pw0); \
    VRD(4); SBAR(); GAPA(C1=__builtin_amdgcn_mfma_f32_32x32x16_bf16(kf[1],qr[0],CIN,0,0,0), P0[6],P0[7],P0[8],P0[9],     pw0[2]=PKW(P0,4), pw0[3]=PKW(P0,6), pw0); \
    VRD(1); SBAR(); GAPA(C0=__builtin_amdgcn_mfma_f32_32x32x16_bf16(kf[2],qr[1],C0,0,0,0),   P0[10],P0[11],P0[12],P0[13], pw1[0]=PKW(P0,8), pw1[1]=PKW(P0,10), pw1); \
    VRD(5); SBAR(); GAPA(C1=__builtin_amdgcn_mfma_f32_32x32x16_bf16(kf[3],qr[1],C1,0,0,0),   P0[14],P0[15],P1[0],P1[1],   pw1[2]=PKW(P0,12),pw1[3]=PKW(P0,14), pw1); \
    VRD(2); SBAR(); GAPA(C0=__builtin_amdgcn_mfma_f32_32x32x16_bf16(kf[4],qr[2],C0,0,0,0),   P1[2],P1[3],P1[4],P1[5],     pw2[0]=PKW(P1,0), pw2[1]=PKW(P1,2), pw2); \
    VRD(6); SBAR(); GAPA(C1=__builtin_amdgcn_mfma_f32_32x32x16_bf16(kf[5],qr[2],C1,0,0,0),   P1[6],P1[7],P1[8],P1[9],     pw2[2]=PKW(P1,4), pw2[3]=PKW(P1,6), pw2); \
    VRD(3); SBAR(); GAPA(C0=__builtin_amdgcn_mfma_f32_32x32x16_bf16(kf[6],qr[3],C0,0,0,0),   P1[10],P1[11],P1[12],P1[13], pw3[0]=PKW(P1,8), pw3[1]=PKW(P1,10), pw3); \
    VRD(7); SBAR(); GAPA(C1=__builtin_amdgcn_mfma_f32_32x32x16_bf16(kf[7],qr[3],C1,0,0,0),   P1[14],P1[15],0.f,0.f,       pw3[2]=PKW(P1,12),pw3[3]=PKW(P1,14), pw3); \
    l_reg+=sacc; \
    if(GK){DMA_K((t)+3,sl_cur);} if(GV){DMA_V((t)+1,sl_next);} \
    ADDB(C0,C1,t); CMASK(C0,C1,t); \
    { float a=MX3(C0[0],C0[1],C1[0]),b=MX3(C0[2],C0[3],C1[1]); a=MX3(a,C1[2],C1[3]); \
      _Pragma("unroll") for(int r=4;r<16;r+=4){a=MX3(a,C0[r],C0[r+1]);b=MX3(b,C0[r+2],C0[r+3]);a=MX3(a,C1[r],C1[r+1]);b=MX3(b,C1[r+2],C1[r+3]);} \
      float rm=__builtin_fmaxf(a,b); { auto rr=__builtin_amdgcn_permlane32_swap(__float_as_uint(rm),__float_as_uint(rm),false,false); rm=__builtin_fmaxf(__uint_as_float(rr[0]),__uint_as_float(rr[1])); } \
      resc=false; \
      if(__builtin_expect(__any(rm>(float)THRL),0)){ const float dl=__builtin_fmaxf(rm,0.f); mhat+=dl; \
        _Pragma("unroll") for(int r=0;r<16;++r){C0[r]-=dl;C1[r]-=dl;} \
        _Pragma("unroll") for(int r=0;r<16;++r)negm[r]=-mhat; asm volatile("":"+v"(negm)); \
        const float f=__builtin_amdgcn_exp2f(-dl); l_reg*=f; if(hi==0)wsf[r32]=f; resc=true; } } \
    SBAR(); \
    GAPB(o[0]=__builtin_amdgcn_mfma_f32_32x32x16_bf16(PAF(0),VFR(0),o[0],0,0,0), C0,0); \
    GAPB(o[1]=__builtin_amdgcn_mfma_f32_32x32x16_bf16(PAF(0),VFR(4),o[1],0,0,0), C0,4); \
    KRD(GL,0); GAPB(o[0]=__builtin_amdgcn_mfma_f32_32x32x16_bf16(PAF(1),VFR(1),o[0],0,0,0), C0,8); \
    KRD(GL,1); GAPB(o[1]=__builtin_amdgcn_mfma_f32_32x32x16_bf16(PAF(1),VFR(5),o[1],0,0,0), C0,12); \
    KRD(GL,2); GAPB(o[0]=__builtin_amdgcn_mfma_f32_32x32x16_bf16(PAF(2),VFR(2),o[0],0,0,0), C1,0); \
    KRD(GL,3); GAPB(o[1]=__builtin_amdgcn_mfma_f32_32x32x16_bf16(PAF(2),VFR(6),o[1],0,0,0), C1,4); \
    GAPB(o[0]=__builtin_amdgcn_mfma_f32_32x32x16_bf16(PAF(3),VFR(3),o[0],0,0,0), C1,8); \
    GAPB(o[1]=__builtin_amdgcn_mfma_f32_32x32x16_bf16(PAF(3),VFR(7),o[1],0,0,0), C1,12); \
    }while(0)
  int t=1;
  #undef CMASK
  #define CMASK(P0,P1,t) do{}while(0)
  for(;t+5<NT;t+=2){
    STEP(pB0,pB1,pA0,pA1,t,true,true,true);     WAIT_BAR(2); RESC(); ROT();
    STEP(pA0,pA1,pB0,pB1,t+1,true,true,true);   WAIT_BAR(2); RESC(); ROT();
  }
  #undef CMASK
  #define CMASK(P0,P1,t) do{int jb_=(t)-(NT-4); if(jb_>=0)cmask_t<MODE>(P0,P1,jb_,qrel,hi,wid);}while(0)
  #define ENDW(tt) do{ if((tt)+3<NT){WAIT_BAR(2);} else if((tt)+2<NT){WAIT_BAR(1);} else {WAIT_BAR(0);} }while(0)
  for(;t+1<NT;t+=2){
    STEP(pB0,pB1,pA0,pA1,t,(t+3<NT),(t+1<NT),(t+1<NT));       ENDW(t);   RESC(); ROT();
    STEP(pA0,pA1,pB0,pB1,t+1,(t+4<NT),(t+2<NT),(t+2<NT));     ENDW(t+1); RESC(); ROT();
  }
  STEP(pB0,pB1,pA0,pA1,NT-1,false,false,false); RESC();
  { float sacc=pB0[0]+pB0[1]; _Pragma("unroll") for(int r=2;r<16;++r)sacc+=pB0[r]; _Pragma("unroll") for(int r=0;r<16;++r)sacc+=pB1[r]; l_reg+=sacc;
    pw0=(u32x4){PKW(pB0,0),PKW(pB0,2),PKW(pB0,4),PKW(pB0,6)};pw1=(u32x4){PKW(pB0,8),PKW(pB0,10),PKW(pB0,12),PKW(pB0,14)};pw2=(u32x4){PKW(pB1,0),PKW(pB1,2),PKW(pB1,4),PKW(pB1,6)};pw3=(u32x4){PKW(pB1,8),PKW(pB1,10),PKW(pB1,12),PKW(pB1,14)};
    SBAR(); pv(o,vb0+sl_cur,PAF(0),PAF(1),PAF(2),PAF(3)); }
  #undef PKW
  #undef PAF
  #undef VFR
  #undef PIN
  #undef MX3
  #undef GAPA
  #undef GAPB
  #undef EX
  #undef VRD
  #undef KRD
  #undef STEP
  #undef ENDW
  {auto rr=__builtin_amdgcn_permlane32_swap(__float_as_uint(l_reg),__float_as_uint(l_reg),false,false);l_reg=__uint_as_float(rr[0])+__uint_as_float(rr[1]);}
  if(hi==0)wsf[32+r32]=l_reg;asm volatile("s_waitcnt lgkmcnt(0)":::"memory");
  float rli[16];
  #pragma unroll
  for(int r=0;r<16;++r)rli[r]=__builtin_amdgcn_rcpf(wsf[32+crow(r,hi)]);
  bf16*Ow=O+(rowbase+q0+wid*QBLK)*DM+ho*D;
  { bf16*stg=(bf16*)(shm+(EPI==1?LDS_X:LDS_OST))+wid*2048;
    #pragma unroll
    for(int r=0;r<16;++r){const int orow=crow(r,hi);
      #pragma unroll
      for(int d0=0;d0<2;++d0)stg[orow*64+d0*32+r32]=__float2bfloat16(o[d0][r]*rli[r]);}
    asm volatile("s_waitcnt lgkmcnt(0)":::"memory");
    #pragma unroll
    for(int i=0;i<4;++i){ if(EPI!=1){ const int row=i*8+(lane>>3),ch=lane&7; u32x4 v=*(const u32x4*)(stg+row*64+ch*8);
      if(EPI==2){ const u32x4 a=*(const u32x4*)((const bf16*)(shm+LDS_X)+wid*2048+row*64+ch*8);
        #pragma unroll
        for(int e=0;e<4;++e){ const float al=__uint_as_float(a[e]<<16),ah=__uint_as_float(a[e]&0xffff0000u),bl=__uint_as_float(v[e]<<16),bh=__uint_as_float(v[e]&0xffff0000u); v[e]=cvtpk_s(al-lam*bl,ah-lam*bh);} }
      ATTN_STORE16(Ow+(long)row*DM+ch*8,v);} } }
  asm volatile("s_waitcnt lgkmcnt(0)\n\ts_barrier":::"memory");
  #undef DMA_K
  #undef DMA_V
  #undef CMASK
  #undef ADDB
  #undef CIN
  #undef START
  #undef RESC
  #undef ROT
}
constexpr int ATTN_LDS_BYTES=LDS_TOTAL;
__device__ __forceinline__ void fox_bias_scan(char*shm,const float*lf){
  const int tid=otid(),lane=tid&63; const int wid=__builtin_amdgcn_readfirstlane(tid>>6);
  float*nb=(float*)(shm+LDS_X); float*wt=(float*)(shm+LDS_WS);
  const f32x4_t a=*(const f32x4_t*)(lf+8*tid), b=*(const f32x4_t*)(lf+8*tid+4);
  float p[8]; p[0]=a[0];p[1]=p[0]+a[1];p[2]=p[1]+a[2];p[3]=p[2]+a[3];p[4]=p[3]+b[0];p[5]=p[4]+b[1];p[6]=p[5]+b[2];p[7]=p[6]+b[3];
  const float tot=p[7]; float inc=tot;
  #pragma unroll
  for(int o=1;o<64;o<<=1){const float t=__shfl_up(inc,o); if(lane>=o)inc+=t;}
  if(lane==63)wt[wid]=inc;
  __syncthreads();
  float off=inc-tot; for(int w=0;w<wid;++w)off+=wt[w];
  const float L2E=1.4426950408889634f;
  *(f32x4_t*)(nb+8*tid)=(f32x4_t){-(off+p[0])*L2E,-(off+p[1])*L2E,-(off+p[2])*L2E,-(off+p[3])*L2E};
  *(f32x4_t*)(nb+8*tid+4)=(f32x4_t){-(off+p[4])*L2E,-(off+p[5])*L2E,-(off+p[6])*L2E,-(off+p[7])*L2E};
  __syncthreads();
}
template<int MODE> __device__ __forceinline__ void attn_phase2(char*lds,const bf16*Q,const bf16*K,const bf16*V,bf16*O,int G,int bx,const float*LFT,float lam,unsigned*qcnt,volatile unsigned*qword,const float*qg,const float*kg){
  if(MODE!=0){
    const int vcu=(bx%8)*(G/8)+bx/8; const int s=vcu&1,g=vcu>>1; const int b=g>>4;
    for(int i=0;i<8;++i){
      const int p=i>>1; const int qb=(i&1)?4*p+3-s:4*p+s;
      if(MODE==2){ const int h=g&15; attn_unit<8,MODE,0>(b,h,h,h,qb,Q,K,V,O,lds,0.f); }
      else { const int hh=(g&15)>>1,vh=g&1; attn_unit<8,1,1>(b,2*hh,2*hh+vh,2*hh+vh,qb,Q,K,V,O,lds,lam); attn_unit<8,1,2>(b,2*hh+1,2*hh+vh,2*hh+vh,qb,Q,K,V,O,lds,lam); }
    }
  } else {
    float gqm=0.f,gkm=0.f; for(int i=0;i<D;++i){gqm=fmaxf(gqm,fabsf(qg[i]));gkm=fmaxf(gkm,fabsf(kg[i]));}
    const float thr=200.0f+2.0f*1.01f*(float)D*C2*gqm*gkm;
    const float*nb=(const float*)(lds+LDS_X); int cur=-1;
    for(;;){
      __syncthreads();
      if(threadIdx.x==0) *qword=__hip_atomic_fetch_add(qcnt,1u,__ATOMIC_RELAXED,__HIP_MEMORY_SCOPE_AGENT);
      __syncthreads();
      const int u=__builtin_amdgcn_readfirstlane((int)*qword); if(u>=BATCH*NHEAD*NQB)break;
      const int qb=NQB-1-(u>>7),g=u&127,b=g>>4,h=g&15;
      if(g!=cur){ fox_bias_scan(lds,LFT+(size_t)g*SEQ); cur=g; }
      const float ref=nb[qb*QB]-thr;
      int lo=0,hi=2*qb;
      while(lo<hi){ const int mid=(lo+hi+1)>>1; if(nb[128*mid-1]<ref)lo=mid; else hi=mid-1; }
      const int t0=__builtin_amdgcn_readfirstlane(2*lo);
      attn_unit<8,0,0>(b,h,h,h,qb,Q,K,V,O,lds,0.f,t0);
    }
  }
}
#undef SBAR
#undef WAIT_BAR
}

namespace cg = cooperative_groups;
#define GAS __attribute__((address_space(1)))
#define LAS __attribute__((address_space(3)))
typedef unsigned short bf16;
typedef unsigned v4u __attribute__((ext_vector_type(4)));
typedef unsigned v2u __attribute__((ext_vector_type(2)));
typedef float f32x4 __attribute__((ext_vector_type(4)));
typedef float f32x2 __attribute__((ext_vector_type(2)));
typedef short bf16x8 __attribute__((ext_vector_type(8)));
#define LDS_WAIT() asm volatile("s_waitcnt lgkmcnt(0)" ::: "memory")
__device__ __forceinline__ unsigned f2bf(float f) { unsigned u = __builtin_bit_cast(unsigned, f); return (u + 0x7fffu + ((u >> 16) & 1u)) >> 16; }
__device__ __forceinline__ unsigned pk2(float lo, float hi) { return f2bf(lo) | (f2bf(hi) << 16); }
__device__ __forceinline__ float bflo(unsigned v) { return __uint_as_float(v << 16); }
__device__ __forceinline__ float bfhi(unsigned v) { return __uint_as_float(v & 0xffff0000u); }

constexpr int NWAVES = 8;
constexpr int BATCH = 8, SEQ = 4096, DM = 1024, DFF = 2816, DEPTH = 4;
constexpr int M = BATCH * SEQ;
constexpr size_t MiB = 1u << 20;
constexpr size_t WS_BAR = 0, BAR_ZERO_BYTES = 16384;
constexpr size_t WS_SSQ = 1 * MiB, WS_LFT = 3 * MiB, WS_ROPE = 5 * MiB, WS_WF = 7 * MiB, WS_W = 8 * MiB, FFN_SLOT = 16 * MiB + MiB / 2, WS_WM = WS_W + 8 * FFN_SLOT, MIX_SLOT = 8 * MiB;
constexpr size_t WS_XB = WS_WM + 4 * MIX_SLOT, WS_Q = WS_XB + 64 * MiB, WS_K = WS_Q + 64 * MiB, WS_V = WS_K + 64 * MiB, WS_O = WS_V + 64 * MiB, WS_END = WS_O + 64 * MiB;
static_assert(WS_XB == 172 * MiB && WS_END == 492 * MiB, "ws map");
constexpr int RING_BYTES = 131072, LDS_BYTES = 147456;
constexpr float LAMBDA_INIT = 0.4707130183435842f;
constexpr int N_PHASES = 1 + 4 * 4 + 3 + 3 + 4 + 3;

struct Args { const float* in[33]; float* out; unsigned char* ws; int ph_lo, ph_hi; };

__device__ __forceinline__ float wave_sum(float v) {
#pragma unroll
    for (int o = 1; o < 64; o <<= 1) v += __shfl_xor(v, o);
    return v;
}

__device__ __forceinline__ void wt_item(const float* W0, const float* W1, int ldw, int K, int N, int kind, const float* gain, int gmask, float gscale, bf16* WT, LAS float* scr, int item, int lane) {
    const int nblk = N / 32, kb = item / nblk, nb = item % nblk, k0 = 64 * kb, R0 = 32 * nb;
    const int n4 = (lane & 7) * 4, kr = lane >> 3;
    const int R = R0 + n4, pn = R >> 8, p = R & 255;
    const float* src;
    if (kind == 0) src = W0 + R;
    else { const int bj = p >> 7, wc = (p >> 5) & 3, r = p & 31;
        if (kind == 1) src = (bj ? W1 : W0) + (128 * pn + (p & 127));
        else src = W0 + (256 * pn + 64 * wc + 32 * bj + r); }
    f32x4 tv[8];
#pragma unroll
    for (int i = 0; i < 8; ++i) tv[i] = *(const GAS f32x4*)(src + (size_t)(k0 + 8 * i + kr) * ldw);
#pragma unroll
    for (int i = 0; i < 8; ++i) { LAS float* d = scr + (8 * i + kr) * 33 + n4; d[0] = tv[i][0]; d[1] = tv[i][1]; d[2] = tv[i][2]; d[3] = tv[i][3]; }
    LDS_WAIT(); asm volatile("" ::: "memory");
    const int c = lane & 7;
    f32x4 g0 = {gscale, gscale, gscale, gscale}, g1 = g0;
    if (gain) { const int kg = (k0 + 8 * c) & gmask; g0 = *(const f32x4*)(gain + kg) * gscale; g1 = *(const f32x4*)(gain + kg + 4) * gscale; }
#pragma unroll
    for (int j = 0; j < 4; ++j) { const int n = (lane >> 3) + 8 * j; const LAS float* s = scr + (8 * c) * 33 + n;
        v4u o; o.x = pk2(s[0 * 33] * g0[0], s[1 * 33] * g0[1]); o.y = pk2(s[2 * 33] * g0[2], s[3 * 33] * g0[3]); o.z = pk2(s[4 * 33] * g1[0], s[5 * 33] * g1[1]); o.w = pk2(s[6 * 33] * g1[2], s[7 * 33] * g1[3]);
        *(GAS v4u*)(WT + (size_t)(R0 + n) * K + k0 + 8 * c) = o; }
    LDS_WAIT(); asm volatile("" ::: "memory");
}

__device__ __forceinline__ bf16* w_gu(unsigned char* ws, int f) { return (bf16*)(ws + WS_W + (size_t)f * FFN_SLOT); }
__device__ __forceinline__ bf16* w_dn(unsigned char* ws, int f) { return (bf16*)(ws + WS_W + (size_t)f * FFN_SLOT + 11 * MiB); }
__device__ __forceinline__ bf16* w_mi(unsigned char* ws, int L) { return (bf16*)(ws + WS_WM + (size_t)L * MIX_SLOT); }
__device__ __forceinline__ bf16* w_mo(unsigned char* ws, int L) { return (bf16*)(ws + WS_WM + (size_t)L * MIX_SLOT + 6 * MiB); }

__device__ __forceinline__ void prologue(const Args& args, LAS unsigned char* lds, int vcu, int G, int wave, int lane, int tid) {
    unsigned char* ws = args.ws;
    LAS float* scr = (LAS float*)(lds + wave * 16384);
    const int gw = vcu * NWAVES + wave, NGW = G * NWAVES;
    int it = gw, base = 0;
    for (int job = 0; job < 24; ++job) {
        const float* W0; const float* W1; int ldw, K, N, kind, gmask = 1023; bf16* Bt; const float* gain = nullptr; float gscale = 1.0f;
        if (job < 16) { const int f = job >> 1, L = f >> 1, which = f & 1;
            if (!(job & 1)) { W0 = (which ? args.in[8] : args.in[5]) + (size_t)L * DM * DFF; W1 = (which ? args.in[9] : args.in[6]) + (size_t)L * DM * DFF; ldw = DFF; K = DM; N = 2 * DFF; kind = 1;
                gain = (which ? args.in[4] : args.in[2]) + L * DM; Bt = w_gu(ws, f); }
            else { W0 = (which ? args.in[10] : args.in[7]) + (size_t)L * DM * DFF; W1 = W0; ldw = DM; K = DFF; N = DM; kind = 0; Bt = w_dn(ws, f); } }
        else { const int L = (job - 16) >> 1, mk = L % 3, idx = L / 3; K = DM;
            if (!(job & 1)) { gain = args.in[3] + L * DM; Bt = w_mi(ws, L);
                if (mk == 0) { W0 = args.in[11] + (size_t)idx * DM * 3088; W1 = W0; ldw = 3088; N = 3072; kind = 2; }
                else if (mk == 1) { W0 = args.in[16]; W1 = args.in[16] + 1024; ldw = 2048; N = 2048; kind = 1; }
                else { W0 = args.in[24]; W1 = W0; ldw = 3072; N = 3072; kind = 2; } }
            else { N = DM; ldw = DM; kind = 0; Bt = w_mo(ws, L);
                if (mk == 0) W0 = args.in[15] + (size_t)idx * DM * DM; else if (mk == 1) W0 = args.in[22]; else { W0 = args.in[32]; gain = args.in[31]; gmask = 127; gscale = 1.0f - LAMBDA_INIT; }
                W1 = W0; } }
        const int items = (K / 64) * (N / 32);
        for (; it < base + items; it += NGW) wt_item(W0, W1, ldw, K, N, kind, gain, gmask, gscale, Bt, scr, it - base, lane);
        base += items;
    }
    { const float* x = args.in[0]; bf16* XB = (bf16*)(ws + WS_XB); float* SSQ = (float*)(ws + WS_SSQ);
        for (int m0 = gw; m0 < M; m0 += 2 * NGW) {
            f32x4 v[2][4]; float s[2];
#pragma unroll
            for (int h = 0; h < 2; ++h) { const int m = m0 + h * NGW; const GAS f32x4* xr = (const GAS f32x4*)(x + (size_t)(m < M ? m : m0) * DM) + lane;
#pragma unroll
                for (int j = 0; j < 4; ++j) v[h][j] = xr[64 * j]; }
#pragma unroll
            for (int h = 0; h < 2; ++h) { const int m = m0 + h * NGW; float t = 0.f;
#pragma unroll
                for (int j = 0; j < 4; ++j) t += (v[h][j].x * v[h][j].x + v[h][j].y * v[h][j].y) + (v[h][j].z * v[h][j].z + v[h][j].w * v[h][j].w);
                s[h] = wave_sum(t);
                if (m < M) { GAS unsigned long long* o8 = (GAS unsigned long long*)(XB + (size_t)m * DM) + lane;
#pragma unroll
                    for (int j = 0; j < 4; ++j) o8[64 * j] = (unsigned long long)pk2(v[h][j].x, v[h][j].y) | ((unsigned long long)pk2(v[h][j].z, v[h][j].w) << 32);
                    if (lane < 4) SSQ[(size_t)m * 4 + lane] = lane == 0 ? s[h] : 0.f; } }
        } }
    { const int* pos = (const int*)args.in[1]; float* RT = (float*)(ws + WS_ROPE);
        for (int e = vcu * 512 + tid; e < M * 8; e += G * 512) {
            const int m = e >> 3, i = e & 7;
            const float fr = i == 0 ? 1.0f : i == 1 ? 0.1939227432012558f : i == 2 ? 0.03760603070259094f : i == 3 ? 0.007292664609849453f : i == 4 ? 0.0014142135623842478f : i == 5 ? 0.00027424818836152554f : i == 6 ? 5.318296098266728e-05f : 1.0313386155758053e-05f;
            const float af = (float)pos[m] * fr; const double a = (double)af;
            const double nq = __builtin_rint(a * 0.6366197723675814);
            double r = __builtin_fma(-nq, 1.5707963267948966, a); r = __builtin_fma(-nq, 6.123233995736766e-17, r);
            const double r2 = r * r;
            double sp = 1.0 / 6227020800.0; sp = sp * r2 - 1.0 / 39916800.0; sp = sp * r2 + 1.0 / 362880.0; sp = sp * r2 - 1.0 / 5040.0; sp = sp * r2 + 1.0 / 120.0; sp = sp * r2 - 1.0 / 6.0; sp = sp * r2 * r + r;
            double cp = -1.0 / 87178291200.0; cp = cp * r2 + 1.0 / 479001600.0; cp = cp * r2 - 1.0 / 3628800.0; cp = cp * r2 + 1.0 / 40320.0; cp = cp * r2 - 1.0 / 720.0; cp = cp * r2 + 1.0 / 24.0; cp = cp * r2 - 0.5; cp = cp * r2 + 1.0;
            const int q = ((int)nq) & 3;
            const double sn = (q == 0) ? sp : (q == 1) ? cp : (q == 2) ? -sp : -cp;
            const double cs = (q == 0) ? cp : (q == 1) ? -sp : (q == 2) ? -cp : sp;
            RT[(size_t)m * 16 + i] = (float)cs; RT[(size_t)m * 16 + 8 + i] = (float)sn;
        } }
    { bf16* WF = (bf16*)(ws + WS_WF);
        for (int e = vcu * 512 + tid; e < 2 * 16 * 1024; e += G * 512) {
            const int idx = e >> 14, h = (e >> 10) & 15, k = e & 1023; const int L = idx * 3;
            WF[e] = (bf16)f2bf(args.in[3][L * DM + k] * args.in[11][(size_t)idx * DM * 3088 + (size_t)k * 3088 + 3072 + h]);
        } }
}

__device__ __forceinline__ void flogit_tasks(const bf16* XB, const bf16* WfT, const float* ssq, const float* b_f, float* LFT, int gw, int NGW, int lane) {
    const int fr = lane & 15, fq = lane >> 4;
    for (int task = gw; task < M / 16; task += NGW) {
        const int row0 = task * 16;
        const bf16x8* ap = (const bf16x8*)(XB + (size_t)(row0 + fr) * DM + 8 * fq);
        const bf16x8* bp = (const bf16x8*)(WfT + (size_t)fr * DM + 8 * fq);
        f32x4 acc = {0.f, 0.f, 0.f, 0.f};
#pragma unroll 8
        for (int kk = 0; kk < 32; ++kk) acc = __builtin_amdgcn_mfma_f32_16x16x32_bf16(ap[kk * 4], bp[kk * 4], acc, 0, 0, 0);
        const float bf = b_f[fr]; f32x4 lf;
#pragma unroll
        for (int i = 0; i < 4; ++i) { const float z = acc[i] * pg8::row_rstd(ssq, row0 + 4 * fq + i) + bf;
            const float e = __expf(-fabsf(z)); lf[i] = fminf(z, 0.f) - __logf(1.0f + e); }
        const int b = row0 >> 12, s = (row0 & 4095) + 4 * fq;
        *(f32x4*)(LFT + ((size_t)(b * 16 + fr) * SEQ + s)) = lf;
    }
}

__device__ __forceinline__ void conv_phase(LAS unsigned char* lds, const bf16* Gb, bf16* Cb, const float* wdw, const float* bdw, const float* lng, const float* lnb, int vcu, int G, int tid, int wave, int lane) {
    LAS float* T = (LAS float*)lds;
    const int c0 = 2 * tid;
    float w0[31], w1[31];
#pragma unroll
    for (int j = 0; j < 31; ++j) { const f32x2 t = *(const f32x2*)(wdw + j * DM + c0); w0[j] = t.x; w1[j] = t.y; }
    const f32x2 bd = *(const f32x2*)(bdw + c0);
    const int per = (2048 + G - 1) / G;
    for (int k = 0; k < per; ++k) {
        const int unit = vcu * per + k; if (unit >= 2048) break;
        const int b = unit >> 8, t0 = (unit & 255) * 16; const size_t rowbase = (size_t)b * SEQ;
        float a0[16], a1[16];
#pragma unroll
        for (int o = 0; o < 16; ++o) { a0[o] = bd.x; a1[o] = bd.y; }
#pragma unroll
        for (int i = 0; i < 46; ++i) {
            const int t = t0 - 30 + i;
            unsigned v = 0u; if (t >= 0) v = *(const unsigned*)(Gb + (rowbase + t) * DM + c0);
            const float x0 = bflo(v), x1 = bfhi(v);
#pragma unroll
            for (int o = 0; o < 16; ++o) { const int j = i - o; if (j >= 0 && j <= 30) { a0[o] += w0[j] * x0; a1[o] += w1[j] * x1; } }
        }
#pragma unroll
        for (int o = 0; o < 16; ++o) *(LAS f32x2*)(T + o * DM + c0) = (f32x2){a0[o], a1[o]};
        __syncthreads();
#pragma unroll
        for (int rr = 0; rr < 2; ++rr) { const int o = 2 * wave + rr;
            f32x4 v[4]; float s = 0.f;
#pragma unroll
            for (int q = 0; q < 4; ++q) { v[q] = *(const LAS f32x4*)(T + o * DM + 4 * lane + 256 * q); s += (v[q].x + v[q].y) + (v[q].z + v[q].w); }
            const float mean = wave_sum(s) * (1.0f / DM); float s2 = 0.f;
#pragma unroll
            for (int q = 0; q < 4; ++q) { v[q] = v[q] - mean; s2 += (v[q].x * v[q].x + v[q].y * v[q].y) + (v[q].z * v[q].z + v[q].w * v[q].w); }
            const float rstd = pg8::rsq_(wave_sum(s2) * (1.0f / DM) + 1e-6f);
            bf16* orow = Cb + (rowbase + t0 + o) * DM;
#pragma unroll
            for (int q = 0; q < 4; ++q) { const f32x4 g = *(const f32x4*)(lng + 4 * lane + 256 * q), bb = *(const f32x4*)(lnb + 4 * lane + 256 * q);
                f32x4 y = v[q] * rstd * g + bb;
#pragma unroll
                for (int e = 0; e < 4; ++e) y[e] = y[e] * pg8::sigm_(y[e]);
                v2u w; w.x = pk2(y[0], y[1]); w.y = pk2(y[2], y[3]); *(v2u*)(orow + 4 * lane + 256 * q) = w; }
        }
        __syncthreads();
    }
}

__device__ __forceinline__ void subnorm_phase(const bf16* Ob, bf16* Nb, int gw, int NGW, int lane) {
    for (int m = gw; m < M; m += NGW) {
        const v4u* ip = (const v4u*)(Ob + (size_t)m * DM + 16 * lane); const v4u a = ip[0], b = ip[1];
        float f[16];
#pragma unroll
        for (int e = 0; e < 4; ++e) { f[2 * e] = bflo(a[e]); f[2 * e + 1] = bfhi(a[e]); f[8 + 2 * e] = bflo(b[e]); f[8 + 2 * e + 1] = bfhi(b[e]); }
        float s = 0.f;
#pragma unroll
        for (int e = 0; e < 16; ++e) s += f[e] * f[e];
        s += __shfl_xor(s, 1); s += __shfl_xor(s, 2); s += __shfl_xor(s, 4);
        const float r = pg8::rsq_(s * (1.0f / 128.0f) + 1e-6f);
        v4u oa, ob;
#pragma unroll
        for (int e = 0; e < 4; ++e) { oa[e] = pk2(f[2 * e] * r, f[2 * e + 1] * r); ob[e] = pk2(f[8 + 2 * e] * r, f[8 + 2 * e + 1] * r); }
        v4u* op = (v4u*)(Nb + (size_t)m * DM + 16 * lane); op[0] = oa; op[1] = ob;
    }
}

#define XB_TMO      128
#define XB_XCNT(j)  (256  + 64 * (j))
#define XB_XSUB(j)  (1280 + 64 * (j))
#define XB_XGEN(j)  (2304 + 64 * (j))
#define XB_TOP      3328
#define XB_TOPGEN   3392
#define XCD_BAR_WORDS 3456
#define XB_SPIN_CAP (1u << 18)

__device__ __forceinline__ unsigned xb_ld(unsigned* p)              { return __hip_atomic_load(p, __ATOMIC_RELAXED, __HIP_MEMORY_SCOPE_AGENT); }
__device__ __forceinline__ unsigned xb_add(unsigned* p, unsigned v) { return __hip_atomic_fetch_add(p, v, __ATOMIC_RELAXED, __HIP_MEMORY_SCOPE_AGENT); }
__device__ __forceinline__ unsigned xb_xcc_id() { return (unsigned)__builtin_amdgcn_s_getreg((3 << 11) | 20) & 0xFu; }
#define XB_SPIN(cond, bar) do { unsigned _sp = 0; while (cond) { __builtin_amdgcn_s_sleep(1); \
    if ((++_sp & 255u) == 0u) { if (xb_ld(&(bar)[XB_TMO])) break; if (_sp > XB_SPIN_CAP) { atomicAdd(&(bar)[XB_TMO], 1u); break; } } } } while (0)

struct XcdBarrier {
    unsigned* bar; unsigned x;
    volatile LAS unsigned* st;
};

__device__ __forceinline__ XcdBarrier xcd_barrier_post(unsigned* bar, volatile LAS unsigned* st) {
    XcdBarrier b; b.bar = bar; b.x = xb_xcc_id(); b.st = st;
    if (threadIdx.x == 0) (void)xb_add(&bar[XB_XCNT(b.x)], 1u);
    return b;
}
__device__ __forceinline__ void xcd_barrier_complete(unsigned* bar, unsigned x, unsigned& nloc, unsigned& nx) {
    const unsigned G = gridDim.x * gridDim.y * gridDim.z;
    unsigned sum, cnt, mine, sp = 0u;
    for (;;) {
        sum = 0u; cnt = 0u; mine = 0u;
#pragma unroll
        for (unsigned j = 0; j < 16; ++j) { const unsigned c = xb_ld(&bar[XB_XCNT(j)]); sum += c; cnt += (c > 0u) ? 1u : 0u; mine = (j == x) ? c : mine; }
        if (sum == G) break;
        __builtin_amdgcn_s_sleep(1);
        if ((++sp & 255u) == 0u) { if (xb_ld(&bar[XB_TMO])) break; if (sp > XB_SPIN_CAP) { atomicAdd(&bar[XB_TMO], 1u); break; } }
    }
    nloc = mine > 0u ? mine : 1u; nx = cnt > 0u ? cnt : 1u;
}

__device__ __forceinline__ void xcd_barrier(const XcdBarrier& b) {
    asm volatile("s_waitcnt vmcnt(0)" ::: "memory");
    __syncthreads();
    if (threadIdx.x == 0) {
        unsigned* bar = b.bar;
        __builtin_amdgcn_s_waitcnt(0);
        unsigned nloc = b.st[0], nx = b.st[1];
        if (nloc == 0u) { xcd_barrier_complete(bar, b.x, nloc, nx); b.st[0] = nloc; b.st[1] = nx; }
        const unsigned old = xb_add(&bar[XB_XSUB(b.x)], 1u);
        const unsigned gen = old / nloc;
        if (old + 1u == (gen + 1u) * nloc) {
            __builtin_amdgcn_fence(__ATOMIC_RELEASE, "agent");
            asm volatile("s_waitcnt vmcnt(0)" ::: "memory");
            const unsigned og = xb_add(&bar[XB_TOP], 1u);
            const unsigned tg = og / nx;
            if (og + 1u == (tg + 1u) * nx) xb_add(&bar[XB_TOPGEN], 1u);
            else XB_SPIN(xb_ld(&bar[XB_TOPGEN]) == tg, bar);
            __builtin_amdgcn_fence(__ATOMIC_ACQUIRE, "agent");
            xb_add(&bar[XB_XGEN(b.x)], 1u);
            asm volatile("s_waitcnt vmcnt(0)" ::: "memory");
        } else {
            XB_SPIN(xb_ld(&bar[XB_XGEN(b.x)]) == gen, bar);
            __builtin_amdgcn_fence(__ATOMIC_ACQUIRE, "agent");
            asm volatile("s_waitcnt vmcnt(0)" ::: "memory");
        }
    }
    __syncthreads();
}

__global__ void __launch_bounds__(NWAVES * 64, 2) mega_fwd(Args args) {
    extern __shared__ __attribute__((aligned(16))) unsigned char lds[];
    cg::grid_group grid = cg::this_grid();
    LAS unsigned char* L3 = (LAS unsigned char*)lds;
#define TID_DEFS const int tid = otid(), lane = tid & 63, wave = __builtin_amdgcn_readfirstlane(tid >> 6); const int gw = vcu * NWAVES + wave, NGW = G * NWAVES; (void)lane; (void)gw; (void)NGW;
    const int G = gridDim.x; const int bx = blockIdx.x; const int vcu = (G % 8 == 0) ? (bx % 8) * (G / 8) + bx / 8 : bx;
    unsigned char* ws = args.ws;
    bf16* XB = (bf16*)(ws + WS_XB); bf16* QB_ = (bf16*)(ws + WS_Q); bf16* KB = (bf16*)(ws + WS_K); bf16* VB = (bf16*)(ws + WS_V); bf16* OB = (bf16*)(ws + WS_O);
    float* SSQ = (float*)(ws + WS_SSQ); float* LFT = (float*)(ws + WS_LFT); const float* ROPE = (const float*)(ws + WS_ROPE);
    const int lo = args.ph_lo, hi = args.ph_hi; int ph = 0;
    volatile LAS unsigned* MISC = (volatile LAS unsigned*)(L3 + RING_BYTES + 2048);
    if (threadIdx.x < 16) MISC[threadIdx.x] = 0u;
    __syncthreads();
    XcdBarrier xbar = xcd_barrier_post((unsigned*)(ws + WS_BAR), MISC);
#define IN_PH() (lo <= ph && ph < hi)
#ifndef PROBE_SYNC
#define PROBE_SYNC 1
#endif
#ifndef PROBE_ATT
#define PROBE_ATT 1
#endif
#ifndef PROBE_RES
#define PROBE_RES 1
#endif
#ifndef PROBE_NOEPI
#define PROBE_NOEPI 0
#endif
#ifndef PROBE_FOXNB
#define PROBE_FOXNB 0
#endif
#ifndef PROBE_IN
#define PROBE_IN 1
#endif
#ifndef PROBE_PRO
#define PROBE_PRO 1
#endif
#ifndef PROBE_MISC
#define PROBE_MISC 1
#endif
#ifndef PROBE_GU
#define PROBE_GU 1
#endif
#define END_PH() do { if (lo <= ph && ph + 1 < hi) { for (int q_ = 0; q_ < PROBE_SYNC; ++q_) { if (lo < 0) grid.sync(); else xcd_barrier(xbar); } } ++ph; } while (0)

#ifndef NO_PRO
    if (IN_PH()) { TID_DEFS for (int rep_ = 0; rep_ < PROBE_PRO; ++rep_) prologue(args, L3, vcu, G, wave, lane, tid); }
#endif
    END_PH();

    for (int st = 0; st < 3 * DEPTH; ++st) {
        const int L = st / 3, r3 = st % 3, mk = L % 3, idx = L / 3;
        const int nsub = (r3 != 1) ? 2 : (mk == 2 ? 4 : 3);
        for (int sp = 0; sp < nsub; ++sp) {
            if (IN_PH()) {
                TID_DEFS
                if (sp == 0 || sp == nsub - 1) {
                    pg8::Gemm g; pg8::EpiP E;
                    E.kind = 0; E.ldo = 0; E.O = nullptr; E.Kd = nullptr; E.Vd = nullptr; E.ssq_in = SSQ; E.bias = nullptr; E.qg = nullptr; E.kg = nullptr; E.rope = ROPE;
                    E.base = nullptr; E.out = args.out; E.xb = XB; E.xbw = XB; E.ssq_out = SSQ; E.alpha = 1.0f; E.qscale = attn_body::C2;
                    g.M = M;
                    if (sp == 0) {
                        g.A = XB; g.K = DM;
                        if (r3 != 1) { const int f = 2 * L + (r3 == 2); g.Bt = w_gu(ws, f); g.N = 2 * DFF; E.kind = 0; E.O = QB_; E.ldo = DFF; }
                        else if (mk == 0) { g.Bt = w_mi(ws, L); g.N = 3072; E.kind = 2; E.O = QB_; E.Kd = KB; E.Vd = VB; E.qg = args.in[13] + idx * 64; E.kg = args.in[14] + idx * 64; }
                        else if (mk == 1) { g.Bt = w_mi(ws, L); g.N = 2048; E.kind = 1; E.O = QB_; E.ldo = DM; E.bias = args.in[17]; }
                        else { g.Bt = w_mi(ws, L); g.N = 3072; E.kind = 3; E.O = QB_; E.Kd = KB; E.Vd = VB; E.qg = args.in[25]; E.kg = args.in[26]; }
                    } else {
                        E.kind = 4; g.N = DM; E.base = (st == 0) ? args.in[0] : (const float*)args.out;
#if RESID_BF16
                        E.out = (st == 3 * DEPTH - 1) ? args.out : nullptr;
#endif
                        if (r3 != 1) { const int f = 2 * L + (r3 == 2); g.A = QB_; g.K = DFF; g.Bt = w_dn(ws, f); E.alpha = 0.5f; }
                        else { g.K = DM; g.Bt = w_mo(ws, L);
                            if (mk == 0) g.A = OB; else if (mk == 1) { g.A = KB; E.bias = args.in[23]; } else g.A = QB_; }
                    }
                    const int nrep = (sp == 0 && r3 != 1) ? PROBE_GU : ((sp == 0 && r3 == 1) ? PROBE_IN : PROBE_RES);
                    const int kind0 = E.kind;
                    for (int rep_ = 0; rep_ < nrep; ++rep_) {
                    E.kind = (PROBE_NOEPI && rep_ + 1 < nrep) ? 9 : kind0;
                    if (sp != 0) { const bool dry = rep_ + 1 < nrep; E.xbw = dry ? ((r3 != 1) ? OB : VB) : XB; E.ssq_out = dry ? LFT : SSQ; }
                    __syncthreads();
                    if (tid == 0) { LAS pg8::EpiP* P = (LAS pg8::EpiP*)(L3 + RING_BYTES + 1024);
                        P->kind = E.kind; P->ldo = E.ldo; P->O = E.O; P->Kd = E.Kd; P->Vd = E.Vd; P->ssq_in = E.ssq_in; P->bias = E.bias; P->qg = E.qg; P->kg = E.kg; P->rope = E.rope;
                        P->base = E.base; P->out = E.out; P->xb = E.xb; P->xbw = E.xbw; P->ssq_out = E.ssq_out; P->alpha = E.alpha; P->qscale = E.qscale; }
                    __syncthreads();
                    pg8::EpiAny EA; EA.P = (const LAS pg8::EpiP*)(L3 + RING_BYTES + 1024); EA.xl = (LAS float*)(L3 + RING_BYTES + 4096);
                    pg8::StaticOrder S; S.init(M, g.N, G, bx);
#ifndef NO_GEMM
                    pg8::gemm_phase<pg8::EpiAny, pg8::StaticOrder, true, true>(L3, g, S, EA);
#endif
                    }
#ifndef NO_FLOG
                    if (sp == 0 && r3 == 1 && mk == 0)
                      for (int rep_ = 0; rep_ < PROBE_MISC; ++rep_)
                        flogit_tasks(XB, (const bf16*)(ws + WS_WF) + (size_t)idx * 16 * DM, SSQ, args.in[12] + idx * 16, LFT, gw, NGW, lane);
#endif
                } else if (mk == 0) {
#if PROBE_FOXNB
                    attn_body::attn_phase2<2>((char*)lds, (const attn_body::bf16*)QB_, (const attn_body::bf16*)KB, (const attn_body::bf16*)VB, (attn_body::bf16*)OB, G, bx, LFT, 0.f, nullptr, nullptr, nullptr, nullptr);
#endif
#ifndef NO_ATT0
                    for (int rep_ = 0; rep_ < PROBE_ATT; ++rep_)
                    attn_body::attn_phase2<0>((char*)lds, (const attn_body::bf16*)QB_, (const attn_body::bf16*)KB, (const attn_body::bf16*)VB, (attn_body::bf16*)OB, G, bx, LFT, 0.f,
                        (unsigned*)(ws + WS_BAR + 14336 + 256 * (idx * PROBE_ATT + rep_)), (volatile unsigned*)(lds + RING_BYTES + 3072), args.in[13] + idx * 64, args.in[14] + idx * 64);
#endif
                } else if (mk == 1) {
#ifndef NO_CONV
                    for (int rep_ = 0; rep_ < PROBE_MISC; ++rep_)
                    conv_phase(L3, QB_, KB, args.in[18], args.in[19], args.in[20], args.in[21], vcu, G, tid, wave, lane);
#endif
                } else if (sp == 1) {
                    float s1 = 0.f, s2 = 0.f;
                    for (int i = 0; i < 64; ++i) { s1 += args.in[27][i] * args.in[28][i]; s2 += args.in[29][i] * args.in[30][i]; }
                    const float lam = __expf(s1) - __expf(s2) + LAMBDA_INIT;
#ifndef NO_ATT1
                    for (int rep_ = 0; rep_ < PROBE_ATT; ++rep_)
                    attn_body::attn_phase2<1>((char*)lds, (const attn_body::bf16*)QB_, (const attn_body::bf16*)KB, (const attn_body::bf16*)VB, (attn_body::bf16*)OB, G, bx, LFT, lam, nullptr, nullptr, nullptr, nullptr);
#endif
                } else {
                    for (int rep_ = 0; rep_ < PROBE_MISC; ++rep_) subnorm_phase(OB, QB_, gw, NGW, lane);
                }
            }
            END_PH();
        }
    }
#undef IN_PH
#undef END_PH
}

#ifndef MK_MULTI
#define MK_MULTI 0
#endif
extern "C" void kernel_launch(void* const* d_in, const int* in_sizes, int n_in, void* d_out, int out_size, void* d_ws, size_t ws_size, hipStream_t stream) {
    static int grid = 0;
    if (grid == 0) {
        if (n_in != 33 || in_sizes[0] != M * DM || out_size != M * DM || ws_size < WS_END) { fprintf(stderr, "kernel_launch: unexpected shapes: n_in %d in0 %d out %d ws %zu (need %zu)\n", n_in, n_in > 0 ? in_sizes[0] : -1, out_size, ws_size, (size_t)WS_END); grid = -1; return; }
        int dev = 0, cus = 0, per_cu = 0;
        hipGetDevice(&dev); hipDeviceGetAttribute(&cus, hipDeviceAttributeMultiprocessorCount, dev);
        if (hipFuncSetAttribute((const void*)mega_fwd, hipFuncAttributeMaxDynamicSharedMemorySize, LDS_BYTES) != hipSuccess) { fprintf(stderr, "kernel_launch: hipFuncSetAttribute failed\n"); grid = -1; return; }
        hipOccupancyMaxActiveBlocksPerMultiprocessor(&per_cu, (const void*)mega_fwd, NWAVES * 64, LDS_BYTES);
        (void)hipGetLastError();
        grid = cus;
        if (grid != 256 || per_cu < 1) fprintf(stderr, "kernel_launch: note: %d CUs, occupancy query %d; built for 256 CUs x 1 workgroup\n", cus, per_cu);
        if (grid != 256) { grid = -1; return; }
    }
    if (grid < 0) return;
    if (hipMemsetAsync((char*)d_ws + WS_BAR, 0, BAR_ZERO_BYTES, stream) != hipSuccess) { fprintf(stderr, "kernel_launch: memset failed\n"); return; }
    Args a{};
    for (int i = 0; i < 33; ++i) a.in[i] = (const float*)d_in[i];
    a.out = (float*)d_out; a.ws = (unsigned char*)d_ws;
#if MK_MULTI
    for (int p = 0; p < N_PHASES; ++p) { a.ph_lo = p; a.ph_hi = p + 1; hipLaunchKernelGGL(mega_fwd, dim3(grid), dim3(NWAVES * 64), LDS_BYTES, stream, a); }
#else
    a.ph_lo = 0; a.ph_hi = N_PHASES;
    void* kargs[] = {&a};
    const hipError_t e = hipLaunchCooperativeKernel((const void*)mega_fwd, dim3(grid), dim3(NWAVES * 64), kargs, LDS_BYTES, stream);
    if (e != hipSuccess) fprintf(stderr, "kernel_launch: cooperative launch failed: %s\n", hipGetErrorString(e));
#endif
}
```

```cpp
#include <hip/hip_runtime.h>
#include <hip/hip_cooperative_groups.h>
#include <hip/hip_bf16.h>
#include <cstdio>
#include <cstdint>
#include <cmath>
__device__ __forceinline__ int otid() { int t = threadIdx.x; asm volatile("" : "+v"(t)); return t; }
namespace pg8 {
#define PG8_LAS __attribute__((address_space(3)))
typedef unsigned short bf16_t;
typedef short bf16x8 __attribute__((ext_vector_type(8)));
typedef float f32x4 __attribute__((ext_vector_type(4)));
typedef unsigned u32x4 __attribute__((ext_vector_type(4)));
constexpr int BM = 256, BK = 64, HALF = 128, HTB = HALF * BK * 2  , STAGE_BYTES = 8 * HTB, NXCD = 8, WGM = 8;

__host__ __device__ __forceinline__ int lds_byte(int r, int c) { const int st = (r >> 4) * 2 + (c >> 5), rr = r & 15, cc = c & 31, ob = rr * 64 + cc * 2; return st * 1024 + (ob ^ (((ob >> 9) & 1) << 5)); }
__host__ __device__ __forceinline__ void stage_rc(int b, int& R, int& C) { const int st = b / 1024, sb = b % 1024, swz = sb ^ (((sb >> 9) & 1) << 5); R = (st >> 1) * 16 + swz / 64; C = (st & 1) * 32 + (swz % 64) / 2; }
__host__ __device__ __forceinline__ int perm32(int rho) { const int n = rho >> 4, i = rho & 15; return 8 * (i >> 2) + 4 * n + (i & 3); }

struct Unit { int pm, pn; };
struct Gemm { const bf16_t* A; const bf16_t* Bt; int M, N, K; };

struct StaticOrder {
    int nM, nN, nwg, G, c;
    __host__ __device__ void init(int M, int N, int G_, int c_) { nM = M / BM; nN = N / BM; nwg = nM * nN; G = G_; c = c_; }
    __host__ __device__ bool next(int i, Unit& u) const {
        const long L = (long)i * G + c; if (L >= nwg) return false;
        int wgid = (int)L; { const int q = nwg / NXCD, r = nwg % NXCD, xcd = wgid % NXCD, off = wgid / NXCD; wgid = (xcd < r ? xcd * (q + 1) : r * (q + 1) + (xcd - r) * q) + off; }
        const int nig = WGM * nN, gid = wgid / nig, fm = gid * WGM, gsz = (nM - fm) < WGM ? (nM - fm) : WGM;
        u.pm = fm + ((wgid % nig) % gsz); u.pn = (wgid % nig) / gsz; return true;
    }
    __device__ __forceinline__ void a_ready(const Unit&) const {}
    __device__ __forceinline__ void done(const Unit&) const {}
};

__device__ __forceinline__ unsigned cvt_pk_bf16(float lo, float hi) { unsigned r; asm volatile("v_cvt_pk_bf16_f32 %0, %1, %2" : "=v"(r) : "v"(lo), "v"(hi)); return r; }
typedef unsigned u32x2 __attribute__((ext_vector_type(2)));
#ifndef RESID_BF16
#define RESID_BF16 1
#endif
constexpr float EPSN = 1e-6f;
#define PG8_GAS __attribute__((address_space(1)))
#ifndef EPI_RS_BATCH
#define EPI_RS_BATCH 1
#endif
#ifndef EPI_PBN
#define EPI_PBN 1
#endif
#ifndef EPI_PB_BATCH
#define EPI_PB_BATCH 1
#endif
__device__ __forceinline__ float rsq_(float v) { return __builtin_amdgcn_rsqf(v); }
__device__ __forceinline__ float sigm_(float v) { return __builtin_amdgcn_rcpf(1.0f + __builtin_amdgcn_exp2f(-1.4426950408889634f * v)); }
__device__ __forceinline__ float xsum16_32(float v) {
    { auto r = __builtin_amdgcn_permlane16_swap(__float_as_uint(v), __float_as_uint(v), false, false); v = __uint_as_float(r[0]) + __uint_as_float(r[1]); }
    { auto r = __builtin_amdgcn_permlane32_swap(__float_as_uint(v), __float_as_uint(v), false, false); v = __uint_as_float(r[0]) + __uint_as_float(r[1]); }
    return v;
}
__device__ __forceinline__ float row_rstd(const float* ssq, int row) {
    const f32x4 s = *(const PG8_GAS f32x4*)(ssq + (size_t)row * 4);
    return rsq_(((s[0] + s[1]) + (s[2] + s[3])) * (1.0f / 1024.0f) + EPSN);
}
struct EpiP { int kind; int ldo; bf16_t* O; bf16_t* Kd; bf16_t* Vd; const float* ssq_in; const float* bias; const float* qg; const float* kg; const float* rope;
    const float* base; float* out; bf16_t* xb; bf16_t* xbw; float* ssq_out; float alpha; float qscale; };
struct EpiAny {
    static constexpr bool PERM = true, AFTER_DRAIN = false;
    const PG8_LAS EpiP* P; PG8_LAS float* xl;
    __device__ __forceinline__ void operator()(const f32x4 (&acc)[2][2][4][2], const Unit& u, int wr, int wc, int fr, int fq) const {
        const int kind = __builtin_amdgcn_readfirstlane(P->kind);
        const float* ssq_in = P->ssq_in; const float* bias = P->bias;
        const int rowt = u.pm * BM + wr * 64 + fr;
        if (kind <= 1) {
            const int colo = u.pn * 128 + wc * 32 + 8 * fq; bf16_t* O = P->O; const int ldo = P->ldo;
            f32x4 bv0[2], bv1[2];
#pragma unroll
            for (int n = 0; n < 2; ++n) { bv0[n] = (f32x4){0.f, 0.f, 0.f, 0.f}; bv1[n] = bv0[n]; }
            if (kind == 1) {
#pragma unroll
                for (int n = 0; n < 2; ++n) { bv0[n] = *(const PG8_GAS f32x4*)(bias + colo + 4 * n); bv1[n] = *(const PG8_GAS f32x4*)(bias + 1024 + colo + 4 * n); }
            }
#pragma unroll
            for (int ai = 0; ai < 2; ++ai) {
                float rs4[4];
#pragma unroll
                for (int m = 0; m < 4; ++m) rs4[m] = EPI_RS_BATCH ? row_rstd(ssq_in, rowt + ai * HALF + m * 16) : 0.f;
#pragma unroll
                for (int m = 0; m < 4; ++m) {
                    const int row = rowt + ai * HALF + m * 16; const float rs = EPI_RS_BATCH ? rs4[m] : row_rstd(ssq_in, row);
                    u32x4 w;
#pragma unroll
                    for (int n = 0; n < 2; ++n) {
                        const f32x4 a0 = acc[ai][0][m][n] * rs + bv0[n], a1 = acc[ai][1][m][n] * rs + bv1[n]; f32x4 r;
                        if (kind == 0) {
#pragma unroll
                            for (int j = 0; j < 4; ++j) r[j] = a0[j] * sigm_(a0[j]) * a1[j];
                        } else {
#pragma unroll
                            for (int j = 0; j < 4; ++j) r[j] = a0[j] * sigm_(a1[j]);
                        }
                        w[2 * n] = cvt_pk_bf16(r[0], r[1]); w[2 * n + 1] = cvt_pk_bf16(r[2], r[3]);
                    }
                    *(PG8_GAS u32x4*)(O + (size_t)row * ldo + colo) = w;
                }
            }
        } else if (kind <= 3) {
            const int sect = u.pn >> 2, pnl = u.pn & 3;
            bf16_t* dst = sect == 0 ? P->O : (sect == 1 ? P->Kd : P->Vd); const float* qg = P->qg; const float* kg = P->kg; const float* rope = P->rope; const float qscale = P->qscale;
            const int colb = pnl * 256 + wc * 64 + 8 * fq;
            f32x4 gv[2][2];
#pragma unroll
            for (int bj = 0; bj < 2; ++bj)
#pragma unroll
                for (int n = 0; n < 2; ++n) gv[bj][n] = (f32x4){1.f, 1.f, 1.f, 1.f};
            if (sect < 2) { const float* g = sect == 0 ? qg : kg; const float sc = sect == 0 ? qscale : 1.0f;
#pragma unroll
                for (int bj = 0; bj < 2; ++bj)
#pragma unroll
                    for (int n = 0; n < 2; ++n) gv[bj][n] = *(const PG8_GAS f32x4*)(g + 32 * bj + 8 * fq + 4 * n) * sc; }
#pragma unroll
            for (int ai = 0; ai < 2; ++ai) {
                float rs4[4];
#pragma unroll
                for (int m = 0; m < 4; ++m) rs4[m] = EPI_RS_BATCH ? row_rstd(ssq_in, rowt + ai * HALF + m * 16) : 0.f;
#pragma unroll
                for (int m = 0; m < 4; ++m) {
                    const int row = rowt + ai * HALF + m * 16; const float rs = EPI_RS_BATCH ? rs4[m] : row_rstd(ssq_in, row);
                    f32x4 v[2][2];
#pragma unroll
                    for (int bj = 0; bj < 2; ++bj)
#pragma unroll
                        for (int n = 0; n < 2; ++n) v[bj][n] = acc[ai][bj][m][n] * rs;
                    if (sect < 2) {
                        float s = 0.f;
#pragma unroll
                        for (int bj = 0; bj < 2; ++bj)
#pragma unroll
                            for (int n = 0; n < 2; ++n) { const f32x4 t = v[bj][n]; s += (t[0] * t[0] + t[1] * t[1]) + (t[2] * t[2] + t[3] * t[3]); }
                        s = xsum16_32(s);
                        const float r = rsq_(s * (1.0f / 64.0f) + EPSN);
#pragma unroll
                        for (int bj = 0; bj < 2; ++bj)
#pragma unroll
                            for (int n = 0; n < 2; ++n) v[bj][n] = v[bj][n] * r * gv[bj][n];
                        if (kind == 3) {
                            const PG8_GAS f32x4* rp = (const PG8_GAS f32x4*)(rope + (size_t)row * 16);
#pragma unroll
                            for (int n = 0; n < 2; ++n) {
                                const f32x4 cs = rp[n], sn = rp[2 + n]; const f32x4 own = v[0][n]; f32x4 oth;
#pragma unroll
                                for (int j = 0; j < 4; ++j) { auto sw = __builtin_amdgcn_permlane16_swap(__float_as_uint(own[j]), __float_as_uint(own[j]), false, false); oth[j] = __uint_as_float((fq & 1) ? sw[0] : sw[1]); }
                                const f32x4 rr = (fq == 0) ? (own * cs - oth * sn) : (own * cs + oth * sn);
                                if (fq < 2) v[0][n] = rr;
                            }
                        }
                    }
#pragma unroll
                    for (int bj = 0; bj < 2; ++bj) {
                        u32x4 w; w[0] = cvt_pk_bf16(v[bj][0][0], v[bj][0][1]); w[1] = cvt_pk_bf16(v[bj][0][2], v[bj][0][3]); w[2] = cvt_pk_bf16(v[bj][1][0], v[bj][1][1]); w[3] = cvt_pk_bf16(v[bj][1][2], v[bj][1][3]);
                        *(PG8_GAS u32x4*)(dst + (size_t)row * 1024 + colb + 32 * bj) = w;
                    }
                }
            }
        } else if (kind == 9) {
            if (u.pm < 0) *(PG8_GAS float*)(P->ssq_out) = acc[0][0][0][0][0] + acc[1][1][3][1][3];
        } else {
            const int col0 = u.pn * BM + wc * 32 + 8 * fq; float* out = P->out; bf16_t* xb = P->xb; bf16_t* xbw = P->xbw; float* ssq_out = P->ssq_out; const float alpha = P->alpha;
            f32x4 bv[2][2];
#pragma unroll
            for (int bj = 0; bj < 2; ++bj)
#pragma unroll
                for (int n = 0; n < 2; ++n) bv[bj][n] = bias ? *(const PG8_GAS f32x4*)(bias + col0 + bj * HALF + n * 4) : (f32x4){0.f, 0.f, 0.f, 0.f};
#pragma unroll
            for (int am = 0; am < 4; ++am) {
                u32x4 pb[2][2];
#pragma unroll
                for (int mm = 0; mm < 2; ++mm)
#pragma unroll
                    for (int bj = 0; bj < 2; ++bj) pb[mm][bj] = *(const PG8_GAS u32x4*)(xb + (size_t)(rowt + (am >> 1) * HALF + ((am & 1) * 2 + mm) * 16) * 1024 + col0 + bj * HALF);
#pragma unroll
                for (int mm = 0; mm < 2; ++mm) { const int ai = am >> 1, m = (am & 1) * 2 + mm;
                    const int row = rowt + ai * HALF + m * 16; const size_t off = (size_t)row * 1024 + col0; float s = 0.f;
#pragma unroll
                    for (int bj = 0; bj < 2; ++bj) {
                        const u32x4 bb = pb[mm][bj]; u32x4 w;
#pragma unroll
                        for (int n = 0; n < 2; ++n) {
                            const f32x4 b = {__uint_as_float(bb[2 * n] << 16), __uint_as_float(bb[2 * n] & 0xffff0000u), __uint_as_float(bb[2 * n + 1] << 16), __uint_as_float(bb[2 * n + 1] & 0xffff0000u)};
                            const f32x4 t = b + (acc[ai][bj][m][n] + bv[bj][n]) * alpha;
                            if (out) *(PG8_GAS f32x4*)(out + off + bj * HALF + n * 4) = t;
                            w[2 * n] = cvt_pk_bf16(t[0], t[1]); w[2 * n + 1] = cvt_pk_bf16(t[2], t[3]);
                            s += (t[0] * t[0] + t[1] * t[1]) + (t[2] * t[2] + t[3] * t[3]);
                        }
                        *(PG8_GAS u32x4*)(xbw + off + bj * HALF) = w;
                    }
                    s = xsum16_32(s);
                    if (fq == 0) xl[(ai * HALF + wr * 64 + m * 16 + fr) * 4 + wc] = s;
                }
            }
            asm volatile("s_waitcnt lgkmcnt(0)" ::: "memory"); __builtin_amdgcn_s_barrier(); asm volatile("" ::: "memory");
            if (wc == 0) {
#pragma unroll
                for (int ai = 0; ai < 2; ++ai) { const int rl = ai * HALF + wr * 64 + fq * 16 + fr; const f32x4 t = *(const PG8_LAS f32x4*)(xl + rl * 4);
                    *(PG8_GAS float*)(ssq_out + (size_t)(u.pm * BM + rl) * 4 + u.pn) = (t[0] + t[1]) + (t[2] + t[3]); }
            }
        }
    }
};
template <class Epi, class Sched, bool ALIGN_EPI = false, bool SP2 = false>
__device__ __forceinline__ void gemm_phase(PG8_LAS unsigned char* lds, const Gemm g, const Sched& S, const Epi& E) {
    const int tid = otid(), wid = __builtin_amdgcn_readfirstlane(tid >> 6), lane = tid & 63, wr = wid >> 2, wc = wid & 3, fr = lane & 15, fq = lane >> 4;
    const int K = g.K, nt = K / BK;
    unsigned voffA[2], voffB[2];
#pragma unroll
    for (int i = 0; i < 2; ++i) { int R, C; stage_rc(tid * 16 + i * 8192, R, C); const int Rb = Epi::PERM ? ((R & ~31) + perm32(R & 31)) : R;
        voffA[i] = (unsigned)(R * K + C) * 2u; voffB[i] = (unsigned)(Rb * K + C) * 2u; }
    const size_t kstep = (size_t)(BK * 2);
    const size_t hstep = (size_t)HALF * K * 2;
    const size_t tstep = 2 * hstep;
    const unsigned ldsw = (unsigned)wid * 1024u;
    const int aoff = lds_byte(wr * 64 + fr, fq * 8), boff = lds_byte(wc * 32 + fr, fq * 8);
#define PG8_SA(b, h) (((b) * 2 + (h)) * HTB)
#define PG8_SB(b, h) ((4 + (b) * 2 + (h)) * HTB)
#define PG8_STAGE(bufoff, gbase, voff) do { _Pragma("unroll") for (int _i = 0; _i < 2; ++_i) \
        __builtin_amdgcn_global_load_lds((const unsigned*)((const char*)(gbase) + (voff)[_i]), (PG8_LAS unsigned*)(lds + (bufoff) + ldsw + _i * 8192), 16, 0, 0); } while (0)
#define PG8_LDA(dst, b, h) do { _Pragma("unroll") for (int m = 0; m < 4; ++m) _Pragma("unroll") for (int k = 0; k < 2; ++k) dst[m][k] = *(const PG8_LAS bf16x8*)(lds + PG8_SA(b, h) + aoff + m * 2048 + k * 1024); } while (0)
#define PG8_LDB(dst, b, h) do { _Pragma("unroll") for (int n = 0; n < 2; ++n) _Pragma("unroll") for (int k = 0; k < 2; ++k) dst[n][k] = *(const PG8_LAS bf16x8*)(lds + PG8_SB(b, h) + boff + n * 2048 + k * 1024); } while (0)
#define PG8_MMA(ai, bj, At, Bt) do { __builtin_amdgcn_s_setprio(1); _Pragma("unroll") for (int m = 0; m < 4; ++m) _Pragma("unroll") for (int n = 0; n < 2; ++n) _Pragma("unroll") for (int k = 0; k < 2; ++k) \
        acc[ai][bj][m][n] = __builtin_amdgcn_mfma_f32_16x16x32_bf16(Bt[n][k], At[m][k], acc[ai][bj][m][n], 0, 0, 0); __builtin_amdgcn_s_setprio(0); } while (0)
#define PG8_WAIT_V(n) asm volatile("s_waitcnt vmcnt(" #n ")" ::: "memory")
#define PG8_WAIT_L(n) asm volatile("s_waitcnt lgkmcnt(" #n ")" ::: "memory")
#define PG8_BAR __builtin_amdgcn_s_barrier()
#define PG8_SCHED __builtin_amdgcn_sched_barrier(0)
    Unit cur, nxt; int ui = 0;
    if (!S.next(0, cur)) return;
    f32x4 acc[2][2][4][2];
#pragma unroll
    for (int a = 0; a < 2; ++a)
#pragma unroll
        for (int b = 0; b < 2; ++b)
#pragma unroll
            for (int m = 0; m < 4; ++m)
#pragma unroll
                for (int n = 0; n < 2; ++n) acc[a][b][m][n] = (f32x4){0.f, 0.f, 0.f, 0.f};
    bf16x8 At[4][2], B0[2][2], B1[2][2];
    const char* cA = (const char*)g.A + (size_t)cur.pm * tstep; const char* cB = (const char*)g.Bt + (size_t)cur.pn * tstep;
    S.a_ready(cur);
    if constexpr (SP2) {
        PG8_STAGE(PG8_SB(0, 0), cB, voffB); PG8_STAGE(PG8_SB(0, 1), cB + hstep, voffB); PG8_STAGE(PG8_SA(0, 0), cA, voffA); PG8_STAGE(PG8_SA(0, 1), cA + hstep, voffA);
        if (wr == 1) PG8_BAR;
        PG8_WAIT_V(2); PG8_BAR;
        PG8_STAGE(PG8_SB(1, 0), cB + kstep, voffB); PG8_STAGE(PG8_SA(1, 0), cA + kstep, voffA); PG8_STAGE(PG8_SB(1, 1), cB + hstep + kstep, voffB);
        PG8_WAIT_V(6); PG8_BAR;
    } else {
        PG8_STAGE(PG8_SB(0, 0), cB, voffB); PG8_STAGE(PG8_SA(0, 0), cA, voffA); PG8_STAGE(PG8_SB(0, 1), cB + hstep, voffB); PG8_STAGE(PG8_SA(0, 1), cA + hstep, voffA);
        if (wr == 1) PG8_BAR;
        PG8_WAIT_V(4); PG8_BAR;
        PG8_STAGE(PG8_SB(1, 0), cB + kstep, voffB); PG8_STAGE(PG8_SA(1, 0), cA + kstep, voffA); PG8_STAGE(PG8_SB(1, 1), cB + hstep + kstep, voffB);
        PG8_WAIT_V(6); PG8_BAR;
    }
    for (;;) {
        const bool has_next = S.next(ui + 1, nxt);
        const char* nA = has_next ? (const char*)g.A + (size_t)nxt.pm * tstep : cA; const char* nB = has_next ? (const char*)g.Bt + (size_t)nxt.pn * tstep : cB;
        for (int t = 0; t < nt; t += 2) {
            const bool last = (t == nt - 2);
            const char* a1 = cA + (size_t)(t + 1) * kstep;
            const char* a2 = last ? nA : cA + (size_t)(t + 2) * kstep; const char* b2 = last ? nB : cB + (size_t)(t + 2) * kstep;
            const char* a3 = a2 + kstep; const char* b3 = b2 + kstep;
            if (last && has_next) S.a_ready(nxt);
            if constexpr (SP2) {
            PG8_LDB(B0, 0, 0); PG8_LDB(B1, 0, 1); PG8_SCHED; PG8_LDA(At, 0, 0); PG8_STAGE(PG8_SA(1, 1), a1 + hstep, voffA);
            PG8_WAIT_V(8); PG8_WAIT_L(0); PG8_BAR; PG8_MMA(0, 0, At, B0); PG8_MMA(0, 1, At, B1); PG8_BAR; PG8_SCHED;
            PG8_LDA(At, 0, 1); PG8_STAGE(PG8_SB(0, 0), b2, voffB); PG8_STAGE(PG8_SB(0, 1), b2 + hstep, voffB); PG8_STAGE(PG8_SA(0, 0), a2, voffA);
            PG8_WAIT_V(8); PG8_WAIT_L(0); PG8_BAR; PG8_MMA(1, 0, At, B0); PG8_MMA(1, 1, At, B1); PG8_BAR; PG8_SCHED;
            PG8_LDB(B0, 1, 0); PG8_LDB(B1, 1, 1); PG8_SCHED; PG8_LDA(At, 1, 0); PG8_STAGE(PG8_SA(0, 1), a2 + hstep, voffA);
            PG8_WAIT_V(8); PG8_WAIT_L(0); PG8_BAR; PG8_MMA(0, 0, At, B0); PG8_MMA(0, 1, At, B1); PG8_BAR; PG8_SCHED;
            PG8_LDA(At, 1, 1); PG8_STAGE(PG8_SB(1, 0), b3, voffB); PG8_STAGE(PG8_SB(1, 1), b3 + hstep, voffB); PG8_STAGE(PG8_SA(1, 0), a3, voffA);
            PG8_WAIT_V(8); PG8_WAIT_L(0); PG8_BAR; PG8_MMA(1, 0, At, B0); PG8_MMA(1, 1, At, B1); PG8_BAR; PG8_SCHED;
            } else {
            PG8_LDB(B0, 0, 0); PG8_SCHED; PG8_LDA(At, 0, 0); PG8_STAGE(PG8_SA(1, 1), a1 + hstep, voffA);
            PG8_WAIT_L(8); PG8_BAR; PG8_WAIT_L(0); PG8_MMA(0, 0, At, B0); PG8_BAR; PG8_SCHED;
            PG8_LDB(B1, 0, 1); PG8_STAGE(PG8_SB(0, 0), b2, voffB);
            PG8_BAR; PG8_WAIT_L(0); PG8_MMA(0, 1, At, B1); PG8_BAR;
            PG8_LDA(At, 0, 1); PG8_STAGE(PG8_SA(0, 0), a2, voffA);
            PG8_BAR; PG8_WAIT_L(0); PG8_MMA(1, 0, At, B0); PG8_BAR; PG8_SCHED;
            PG8_STAGE(PG8_SB(0, 1), b2 + hstep, voffB);
            PG8_WAIT_V(6); PG8_BAR; PG8_MMA(1, 1, At, B1); PG8_BAR;
            PG8_LDB(B0, 1, 0); PG8_SCHED; PG8_LDA(At, 1, 0); PG8_STAGE(PG8_SA(0, 1), a2 + hstep, voffA);
            PG8_WAIT_L(8); PG8_BAR; PG8_WAIT_L(0); PG8_MMA(0, 0, At, B0); PG8_BAR; PG8_SCHED;
            PG8_LDB(B1, 1, 1); PG8_STAGE(PG8_SB(1, 0), b3, voffB);
            PG8_BAR; PG8_WAIT_L(0); PG8_MMA(0, 1, At, B1); PG8_BAR;
            PG8_LDA(At, 1, 1); PG8_STAGE(PG8_SA(1, 0), a3, voffA);
            PG8_BAR; PG8_WAIT_L(0); PG8_MMA(1, 0, At, B0); PG8_BAR; PG8_SCHED;
            PG8_STAGE(PG8_SB(1, 1), b3 + hstep, voffB);
            PG8_WAIT_V(6); PG8_BAR; PG8_MMA(1, 1, At, B1); PG8_BAR;
            }
        }
        if constexpr (ALIGN_EPI) { if (wr == 0) PG8_BAR; }
        if constexpr (!Epi::AFTER_DRAIN) { E(acc, cur, wr, wc, fr, fq); S.done(cur); }
        if (!has_next) break;
#pragma unroll
        for (int a = 0; a < 2; ++a)
#pragma unroll
            for (int b = 0; b < 2; ++b)
#pragma unroll
                for (int m = 0; m < 4; ++m)
#pragma unroll
                    for (int n = 0; n < 2; ++n) acc[a][b][m][n] = (f32x4){0.f, 0.f, 0.f, 0.f};
        cur = nxt; cA = nA; cB = nB; ++ui;
        if constexpr (ALIGN_EPI) { if (wr == 1) PG8_BAR; }
    }
    PG8_WAIT_V(0);
    if constexpr (!ALIGN_EPI) { if (wr == 0) PG8_BAR; }
    PG8_BAR;
    if constexpr (Epi::AFTER_DRAIN) { E.fused(acc, cur, wr, wc, fr, fq, lds, wid, lane); S.done(cur); }
#undef PG8_SA
#undef PG8_SB
#undef PG8_STAGE
#undef PG8_LDA
#undef PG8_LDB
#undef PG8_MMA
#undef PG8_WAIT_V
#undef PG8_WAIT_L
#undef PG8_BAR
#undef PG8_SCHED
}
}

#include <hip/hip_bf16.h>
#include <cmath>
namespace attn_body {
using bf16=__hip_bfloat16;
using bf16x8=__attribute__((ext_vector_type(8)))short;
using s16x4=__attribute__((ext_vector_type(4)))short;
using f32x16=__attribute__((ext_vector_type(16)))float;
using u32x4=__attribute__((ext_vector_type(4)))unsigned;
constexpr int BATCH=8,NHEAD=16,SEQ=4096,D=64,DM=NHEAD*D;
constexpr int NW=8,QBLK=32,QB=QBLK*NW,KVBLK=64,NQB=SEQ/QB;
constexpr int ATTN_PITCH=DM, ATTN_UNIT_ROWS=QB;
__device__ __forceinline__ int crow(int r,int hi){return (r&3)+8*(r>>2)+4*hi;}
#define SBAR() __builtin_amdgcn_sched_barrier(0)
__device__ __forceinline__ void cmask(f32x16&p0,f32x16&p1,int jb,int qrel,int hi){
  const float NEG=-INFINITY; int kb=64*jb+4*hi;
  #pragma unroll
  for(int r=0;r<16;++r){int kv=kb+(r&3)+8*(r>>2); if(kv>qrel)p0[r]=NEG; if(kv+32>qrel)p1[r]=NEG;}
}

template<int MODE> __device__ __forceinline__ void cmask_t(f32x16&p0,f32x16&p1,int jb,int qrel,int hi,int wid){
  if(MODE!=1){cmask(p0,p1,jb,qrel,hi);} else { if(jb>(wid>>1)){ const float NEG=-INFINITY;
    #pragma unroll
    for(int r=0;r<16;++r){p0[r]=NEG;p1[r]=NEG;} } } }
typedef float f32x4_t __attribute__((ext_vector_type(4)));
constexpr int NSLOT=3, SLOTB=8192;
constexpr int LDS_K=0, LDS_V=NSLOT*SLOTB, LDS_WS=2*NSLOT*SLOTB, LDS_OST=LDS_WS+NW*64*4, LDS_BYTES=LDS_OST+NW*4096, LDS_X=LDS_BYTES, LDS_TOTAL=LDS_X+32768;
constexpr float C2=0.125f*1.4426950408889634f;
__device__ __forceinline__ void glds16(const void*gsrc,unsigned lds_dst){unsigned keep;
  asm volatile("s_mov_b32 %0, m0\n\ts_mov_b32 m0, %2\n\ts_nop 0\n\tglobal_load_lds_dwordx4 %1, off\n\ts_mov_b32 m0, %0":"=&s"(keep):"v"(gsrc),"s"(lds_dst):"memory");}
__device__ __forceinline__ float max3f(float a,float b,float c){float r;asm("v_max3_f32 %0, %1, %2, %3":"=v"(r):"v"(a),"v"(b),"v"(c));return r;}
__device__ __forceinline__ float max2f(float a,float b){float r;asm("v_max_f32_e32 %0, %1, %2":"=v"(r):"v"(a),"v"(b));return r;}
__device__ __forceinline__ float fadd_s(float a,float b){float r;asm("v_add_f32_e32 %0, %1, %2":"=v"(r):"v"(a),"v"(b));return r;}
__device__ __forceinline__ float fsub_s(float a,float b){float r;asm("v_sub_f32_e32 %0, %1, %2":"=v"(r):"v"(a),"v"(b));return r;}
typedef float f32x2_t __attribute__((ext_vector_type(2))); typedef __bf16 bf16x2_t __attribute__((ext_vector_type(2)));
__device__ __forceinline__ unsigned cvtpk_s(float lo,float hi){f32x2_t v={lo,hi};bf16x2_t b=__builtin_convertvector(v,bf16x2_t);return __builtin_bit_cast(unsigned,b);}
#define WAIT_BAR(N) asm volatile("s_waitcnt vmcnt(" #N ") lgkmcnt(0)\n\ts_barrier":::"memory")

__device__ __forceinline__ void qkt(f32x16&p0,f32x16&p1,const char*Kslot,const bf16x8*qr,const f32x16&negm,int r32,int hi){
  const char*kb=Kslot+hi*1024+r32*16;
  #pragma unroll
  for(int d0=0;d0<4;++d0){
    const bf16x8 b0=*reinterpret_cast<const bf16x8*>(kb+d0*2048);
    const bf16x8 b1=*reinterpret_cast<const bf16x8*>(kb+d0*2048+512);
    if(d0==0){p0=__builtin_amdgcn_mfma_f32_32x32x16_bf16(b0,qr[0],negm,0,0,0);p1=__builtin_amdgcn_mfma_f32_32x32x16_bf16(b1,qr[0],negm,0,0,0);}
    else{p0=__builtin_amdgcn_mfma_f32_32x32x16_bf16(b0,qr[d0],p0,0,0,0);p1=__builtin_amdgcn_mfma_f32_32x32x16_bf16(b1,qr[d0],p1,0,0,0);}}
}
typedef __attribute__((address_space(3))) const char* lds_cptr;
typedef short v4i16_t __attribute__((ext_vector_type(4)));
__device__ __forceinline__ void kload8(bf16x8*kf,lds_cptr kp){
  kf[0]=*(const __attribute__((address_space(3))) bf16x8*)(kp);      kf[1]=*(const __attribute__((address_space(3))) bf16x8*)(kp+512);
  kf[2]=*(const __attribute__((address_space(3))) bf16x8*)(kp+2048); kf[3]=*(const __attribute__((address_space(3))) bf16x8*)(kp+2560);
  kf[4]=*(const __attribute__((address_space(3))) bf16x8*)(kp+4096); kf[5]=*(const __attribute__((address_space(3))) bf16x8*)(kp+4608);
  kf[6]=*(const __attribute__((address_space(3))) bf16x8*)(kp+6144); kf[7]=*(const __attribute__((address_space(3))) bf16x8*)(kp+6656);
}
__device__ __forceinline__ void kload2(bf16x8*kf,lds_cptr kp,int j){ kf[2*j]=*(const __attribute__((address_space(3))) bf16x8*)(kp+j*2048); kf[2*j+1]=*(const __attribute__((address_space(3))) bf16x8*)(kp+j*2048+512); }
__device__ __forceinline__ s16x4 vtr(lds_cptr p){ return __builtin_bit_cast(s16x4,__builtin_amdgcn_ds_read_tr16_b64_v4i16((__attribute__((address_space(3))) v4i16_t*)p)); }
__device__ __forceinline__ float rowmax(const f32x16&p0,const f32x16&p1){
  float a=max3f(p0[0],p0[1],p1[0]),b=max3f(p0[2],p0[3],p1[1]);a=max3f(a,p1[2],p1[3]);
  #pragma unroll
  for(int r=4;r<16;r+=4){a=max3f(a,p0[r],p0[r+1]);b=max3f(b,p0[r+2],p0[r+3]);a=max3f(a,p1[r],p1[r+1]);b=max3f(b,p1[r+2],p1[r+3]);}
  const float m=max2f(a,b);
  auto rr=__builtin_amdgcn_permlane32_swap(__float_as_uint(m),__float_as_uint(m),false,false);
  return max2f(__uint_as_float(rr[0]),__uint_as_float(rr[1]));
}
__device__ __forceinline__ void pv(f32x16*o,int vb,bf16x8 pa0,bf16x8 pa1,bf16x8 pa2,bf16x8 pa3){
  #pragma unroll
  for(int d0=0;d0<2;++d0){s16x4 lo[4],hi[4];
    #pragma unroll
    for(int ks=0;ks<4;++ks){
      asm volatile("ds_read_b64_tr_b16 %0,%1 offset:%c2":"=&v"(lo[ks]):"v"(vb),"i"(d0*4096+ks*1024):"memory");
      asm volatile("ds_read_b64_tr_b16 %0,%1 offset:%c2":"=&v"(hi[ks]):"v"(vb),"i"(d0*4096+ks*1024+512):"memory");}
    asm volatile("s_waitcnt lgkmcnt(0)":::"memory");SBAR();
    #define PK(k) (bf16x8){lo[k][0],lo[k][1],lo[k][2],lo[k][3],hi[k][0],hi[k][1],hi[k][2],hi[k][3]}
    o[d0]=__builtin_amdgcn_mfma_f32_32x32x16_bf16(pa0,PK(0),o[d0],0,0,0);
    o[d0]=__builtin_amdgcn_mfma_f32_32x32x16_bf16(pa1,PK(1),o[d0],0,0,0);
    o[d0]=__builtin_amdgcn_mfma_f32_32x32x16_bf16(pa2,PK(2),o[d0],0,0,0);
    o[d0]=__builtin_amdgcn_mfma_f32_32x32x16_bf16(pa3,PK(3),o[d0],0,0,0);
    #undef PK
  }
}

#ifndef ATTN_STORE16
#define ATTN_STORE16(p,v) (*(u32x4*)(p)=(v))
#endif
template<int THRL,int MODE,int EPI> __device__ __forceinline__ void attn_unit(int b,int hq,int hv,int ho,int qb,const bf16*Q,const bf16*__restrict__ K,const bf16*__restrict__ V,bf16*O,char*shm,float lam,int t0=0){
  const int tid=otid(),lane=tid&63,r32=lane&31,hi=lane>>5; const int wid=__builtin_amdgcn_readfirstlane(tid>>6);
  const long rowbase=(long)b*SEQ; const int q0=qb*QB;
  const bf16*Qw=Q+(rowbase+q0+wid*QBLK)*DM+hq*D;
  const bf16*Kh=K+(rowbase+(long)t0*KVBLK)*DM+hq*D,*Vh=V+(rowbase+(long)t0*KVBLK)*DM+hv*D;
  const float*nbl=(const float*)(shm+LDS_X)+t0*KVBLK;
  const unsigned lds0=(unsigned)(uintptr_t)shm;
  float*wsf=(float*)(shm+LDS_WS)+wid*64;
  const bf16*ksrc=Kh+(long)lane*DM+wid*8;
  const bf16*vsrc=Vh+(long)(16*(wid&3)+(lane>>2))*DM+(wid>>2)*32+(lane&3)*8;
  const unsigned kdst=lds0+LDS_K+wid*1024, vdst=lds0+LDS_V+wid*1024;
  #define DMA_K(t,slot) glds16(ksrc+(long)(t)*KVBLK*DM,(unsigned)__builtin_amdgcn_readfirstlane(kdst+(slot)))
  #define DMA_V(t,slot) glds16(vsrc+(long)(t)*KVBLK*DM,(unsigned)__builtin_amdgcn_readfirstlane(vdst+(slot)))
  const int vb0=(int)(lds0+LDS_V)+((lane>>4)&1)*32+(lane&3)*8+(4*hi+((lane&15)>>2))*64;
  const char*Kbase=shm+LDS_K; bf16x8 kf[8];
  const lds_cptr shm3=(lds_cptr)shm; const lds_cptr kp0=shm3+LDS_K+hi*1024+r32*16; const lds_cptr vp0=shm3+LDS_V+((lane>>4)&1)*32+(lane&3)*8+(4*hi+((lane&15)>>2))*64;
  const int NT=(q0+QB)/KVBLK-t0;
  DMA_K(0,0);DMA_V(0,0);DMA_K(1,SLOTB);
  bf16x8 qr[4];
  #pragma unroll
  for(int d0=0;d0<4;++d0)qr[d0]=*reinterpret_cast<const bf16x8*>(&Qw[(long)r32*DM+d0*16+hi*8]);
  float mhat=0.f,l_reg=0.f;f32x16 o[2];o[0]=f32x16{};o[1]=f32x16{};f32x16 negm=f32x16{};asm volatile("":"+v"(negm)); const f32x16 zero16=f32x16{};
  #define CIN (MODE==0?zero16:negm)
  const int qrel=wid*QBLK+r32;
  #define ADDB(P0,P1,t) do{ if(MODE==0){ const float*nbp_=nbl+64*(t)+4*hi; _Pragma("unroll") for(int g_=0;g_<4;++g_){ const f32x4_t b0_=*(const f32x4_t*)(nbp_+8*g_); const f32x4_t b1_=*(const f32x4_t*)(nbp_+32+8*g_); _Pragma("unroll") for(int j_=0;j_<4;++j_){P0[4*g_+j_]+=(b0_[j_]-mhat);P1[4*g_+j_]+=(b1_[j_]-mhat);} } } }while(0)
  #define CMASK(P0,P1,t) do{int jb_=(t)-(NT-4); if(jb_>=0)cmask_t<MODE>(P0,P1,jb_,qrel,hi,wid);}while(0)
  bool resc=false;
  #define START(P0,P1) do{ const float rm=rowmax(P0,P1); resc=false; \
    { const float dl=rm; mhat=fadd_s(mhat,dl); \
      _Pragma("unroll") for(int r=0;r<16;++r){P0[r]=fsub_s(P0[r],dl);P1[r]=fsub_s(P1[r],dl);} \
      _Pragma("unroll") for(int r=0;r<16;++r)negm[r]=-mhat; asm volatile("":"+v"(negm)); } \
    _Pragma("unroll") for(int r=0;r<16;++r)P0[r]=__builtin_amdgcn_exp2f(P0[r]); }while(0)
  #define RESC() do{ if(resc){ asm volatile("s_waitcnt lgkmcnt(0)":::"memory"); \
      _Pragma("unroll") for(int d_=0;d_<2;++d_) _Pragma("unroll") for(int r=0;r<16;++r)o[d_][r]*=wsf[crow(r,hi)]; } }while(0)
  f32x16 pA0,pA1,pB0,pB1;
  int sl_prev=0,sl_cur=0,sl_next=SLOTB;
  #define ROT() do{sl_prev=sl_cur;sl_cur=sl_next;sl_next=(sl_next==(NSLOT-1)*SLOTB)?0:sl_next+SLOTB;}while(0)
  DMA_K(2,2*SLOTB);
  WAIT_BAR(3);
  qkt(pA0,pA1,Kbase,qr,CIN,r32,hi);asm volatile("s_nop 15\n\ts_nop 7":"+v"(pA0),"+v"(pA1));ADDB(pA0,pA1,0);CMASK(pA0,pA1,0);
  START(pA0,pA1);
  _Pragma("unroll") for(int r=0;r<16;++r)pA1[r]=__builtin_amdgcn_exp2f(pA1[r]);
  WAIT_BAR(0);
  DMA_K(3,0);DMA_V(1,SLOTB);
  ROT();
  kload8(kf,kp0+sl_cur);
  WAIT_BAR(2);
  s16x4 vlo[8],vhi[8]; u32x4 pw0,pw1,pw2,pw3;
  #define PKW(P,B) cvtpk_s(P[B],P[B+1])
  #define PAF(k) __builtin_bit_cast(bf16x8,pw##k)
  #define VFR(i) (bf16x8){vlo[i][0],vlo[i][1],vlo[i][2],vlo[i][3],vhi[i][0],vhi[i][1],vhi[i][2],vhi[i][3]}
  #define PIN(x) asm volatile("":"+v"(x))
  #define MX3(a,b,c) __builtin_fmaxf(__builtin_fmaxf((a),(b)),(c))
  #define GAPA(MF,A0,A1,A2,A3,W0,W1,PW) do{ MF; sacc+=A0; sacc+=A1; sacc+=A2; sacc+=A3; PIN(sacc); W0; W1; PIN(PW); SBAR(); }while(0)
  #define EX(v) __builtin_amdgcn_exp2f(v)
  #define GAPB(MF,X,B) do{ MF; X[B]=EX(X[B]); X[B+1]=EX(X[B+1]); X[B+2]=EX(X[B+2]); X[B+3]=EX(X[B+3]); PIN(X); SBAR(); }while(0)
  #define VRD(i) do{ vlo[i]=vtr(vp_+(((i)>>2)*4096+((i)&3)*1024)); vhi[i]=vtr(vp_+(((i)>>2)*4096+((i)&3)*1024+512)); }while(0)
  #define KRD(G,j) do{ if(G){ kload2(kf,kp0+sl_next,j); SBAR(); } }while(0)
  #define STEP(C0,C1,P0,P1,t,GK,GV,GL) do{ SBAR(); \
    const lds_cptr vp_=vp0+sl_prev; \
    VRD(0); SBAR(); float sacc=(P0[0]+P0[1]); \
    GAPA(C0=__builtin_amdgcn_mfma_f32_32x32x16_bf16(kf[0],qr[0],CIN,0,0,0), P0[2],P0[3],P0[4],P0[5],     pw0[0]=PKW(P0,0), pw0[1]=PKW(P0,2), pw0); \
    VRD(4); SBAR(); GAPA(C1=__builtin_amdgcn_mfma_f32_32x32x16_bf16(kf[1],qr[0],CIN,0,0,0), P0[6],P0[7],P0[8],P0[9],     pw0[2]=PKW(P0,4), pw0[3]=PKW(P0,6), pw0); \
    VRD(1); SBAR(); GAPA(C0=__builtin_amdgcn_mfma_f32_32x32x16_bf16(kf[2],qr[1],C0,0,0,0),   P0[10],P0[11],P0[12],P0[13], pw1[0]=PKW(P0,8), pw1[1]=PKW(P0,10), pw1); \
    VRD(5); SBAR(); GAPA(C1=__builtin_amdgcn_mfma_f32_32x32x16_bf16(kf[3],qr[1],C1,0,0,0),   P0[14],P0[15],P1[0],P1[1],   pw1[2]=PKW(P0,12),pw1[3]=PKW(P0,14), pw1); \
    VRD(2); SBAR(); GAPA(C0=__builtin_amdgcn_mfma_f32_32x32x16_bf16(kf[4],qr[2],C0,0,0,0),   P1[2],P1[3],P1[4],P1[5],     pw2[0]=PKW(P1,0), pw2[1]=PKW(P1,2), pw2); \
    VRD(6); SBAR(); GAPA(C1=__builtin_amdgcn_mfma_f32_32x32x16_bf16(kf[5],qr[2],C1,0,0,0),   P1[6],P1[7],P1[8],P1[9],     pw2[2]=PKW(P1,4), pw2[3]=PKW(P1,6), pw2); \
    VRD(3); SBAR(); GAPA(C0=__builtin_amdgcn_mfma_f32_32x32x16_bf16(kf[6],qr[3],C0,0,0,0),   P1[10],P1[11],P1[12],P1[13], pw3[0]=PKW(P1,8), pw3[1]=PKW(P1,10), pw3); \
    VRD(7); SBAR(); GAPA(C1=__builtin_amdgcn_mfma_f32_32x32x16_bf16(kf[7],qr[3],C1,0,0,0),   P1[14],P1[15],0.f,0.f,       pw3[2]=PKW(P1,12),pw3[3]=PKW(P1,14), pw3); \
    l_reg+=sacc; \
    if(GK){DMA_K((t)+3,sl_cur);} if(GV){DMA_V((t)+1,sl_next);} \
    ADDB(C0,C1,t); CMASK(C0,C1,t); \
    { float a=MX3(C0[0],C0[1],C1[0]),b=MX3(C0[2],C0[3],C1[1]); a=MX3(a,C1[2],C1[3]); \
      _Pragma("unroll") for(int r=4;r<16;r+=4){a=MX3(a,C0[r],C0[r+1]);b=MX3(b,C0[r+2],C0[r+3]);a=MX3(a,C1[r],C1[r+1]);b=MX3(b,C1[r+2],C1[r+3]);} \
      float rm=__builtin_fmaxf(a,b); { auto rr=__builtin_amdgcn_permlane32_swap(__float_as_uint(rm),__float_as_uint(rm),false,false); rm=__builtin_fmaxf(__uint_as_float(rr[0]),__uint_as_float(rr[1])); } \
      resc=false; \
      if(__builtin_expect(__any(rm>(float)THRL),0)){ const float dl=__builtin_fmaxf(rm,0.f); mhat+=dl; \
        _Pragma("unroll") for(int r=0;r<16;++r){C0[r]-=dl;C1[r]-=dl;} \
        _Pragma("unroll") for(int r=0;r<16;++r)negm[r]=-mhat; asm volatile("":"+v"(negm)); \
        const float f=__builtin_amdgcn_exp2f(-dl); l_reg*=f; if(hi==0)wsf[r32]=f; resc=true; } } \
    SBAR(); \
    GAPB(o[0]=__builtin_amdgcn_mfma_f32_32x32x16_bf16(PAF(0),VFR(0),o[0],0,0,0), C0,0); \
    GAPB(o[1]=__builtin_amdgcn_mfma_f32_32x32x16_bf16(PAF(0),VFR(4),o[1],0,0,0), C0,4); \
    KRD(GL,0); GAPB(o[0]=__builtin_amdgcn_mfma_f32_32x32x16_bf16(PAF(1),VFR(1),o[0],0,0,0), C0,8); \
    KRD(GL,1); GAPB(o[1]=__builtin_amdgcn_mfma_f32_32x32x16_bf16(PAF(1),VFR(5),o[1],0,0,0), C0,12); \
    KRD(GL,2); GAPB(o[0]=__builtin_amdgcn_mfma_f32_32x32x16_bf16(PAF(2),VFR(2),o[0],0,0,0), C1,0); \
    KRD(GL,3); GAPB(o[1]=__builtin_amdgcn_mfma_f32_32x32x16_bf16(PAF(2),VFR(6),o[1],0,0,0), C1,4); \
    GAPB(o[0]=__builtin_amdgcn_mfma_f32_32x32x16_bf16(PAF(3),VFR(3),o[0],0,0,0), C1,8); \
    GAPB(o[1]=__builtin_amdgcn_mfma_f32_32x32x16_bf16(PAF(3),VFR(7),o[1],0,0,0), C1,12); \
    }while(0)
  int t=1;
  #undef CMASK
  #define CMASK(P0,P1,t) do{}while(0)
  for(;t+5<NT;t+=2){
    STEP(pB0,pB1,pA0,pA1,t,true,true,true);     WAIT_BAR(2); RESC(); ROT();
    STEP(pA0,pA1,pB0,pB1,t+1,true,true,true);   WAIT_BAR(2); RESC(); ROT();
  }
  #undef CMASK
  #define CMASK(P0,P1,t) do{int jb_=(t)-(NT-4); if(jb_>=0)cmask_t<MODE>(P0,P1,jb_,qrel,hi,wid);}while(0)
  #define ENDW(tt) do{ if((tt)+3<NT){WAIT_BAR(2);} else if((tt)+2<NT){WAIT_BAR(1);} else {WAIT_BAR(0);} }while(0)
  for(;t+1<NT;t+=2){
    STEP(pB0,pB1,pA0,pA1,t,(t+3<NT),(t+1<NT),(t+1<NT));       ENDW(t);   RESC(); ROT();
    STEP(pA0,pA1,pB0,pB1,t+1,(t+4<NT),(t+2<NT),(t+2<NT));     ENDW(t+1); RESC(); ROT();
  }
  STEP(pB0,pB1,pA0,pA1,NT-1,false,false,false); RESC();
  { float sacc=pB0[0]+pB0[1]; _Pragma("unroll") for(int r=2;r<16;++r)sacc+=pB0[r]; _Pragma("unroll") for(int r=0;r<16;++r)sacc+=pB1[r]; l_reg+=sacc;
    pw0=(u32x4){PKW(pB0,0),PKW(pB0,2),PKW(pB0,4),PKW(pB0,6)};pw1=(u32x4){PKW(pB0,8),PKW(pB0,10),PKW(pB0,12),PKW(pB0,14)};pw2=(u32x4){PKW(pB1,0),PKW(pB1,2),PKW(pB1,4),PKW(pB1,6)};pw3=(u32x4){PKW(pB1,8),PKW(pB1,10),PKW(pB1,12),PKW(pB1,14)};
    SBAR(); pv(o,vb0+sl_cur,PAF(0),PAF(1),PAF(2),PAF(3)); }
  #undef PKW
  #undef PAF
  #undef VFR
  #undef PIN
  #undef MX3
  #undef GAPA
  #undef GAPB
  #undef EX
  #undef VRD
  #undef KRD
  #undef STEP
  #undef ENDW
  {auto rr=__builtin_amdgcn_permlane32_swap(__float_as_uint(l_reg),__float_as_uint(l_reg),false,false);l_reg=__uint_as_float(rr[0])+__uint_as_float(rr[1]);}
  if(hi==0)wsf[32+r32]=l_reg;asm volatile("s_waitcnt lgkmcnt(0)":::"memory");
  float rli[16];
  #pragma unroll
  for(int r=0;r<16;++r)rli[r]=__builtin_amdgcn_rcpf(wsf[32+crow(r,hi)]);
  bf16*Ow=O+(rowbase+q0+wid*QBLK)*DM+ho*D;
  { bf16*stg=(bf16*)(shm+(EPI==1?LDS_X:LDS_OST))+wid*2048;
    #pragma unroll
    for(int r=0;r<16;++r){const int orow=crow(r,hi);
      #pragma unroll
      for(int d0=0;d0<2;++d0)stg[orow*64+d0*32+r32]=__float2bfloat16(o[d0][r]*rli[r]);}
    asm volatile("s_waitcnt lgkmcnt(0)":::"memory");
    #pragma unroll
    for(int i=0;i<4;++i){ if(EPI!=1){ const int row=i*8+(lane>>3),ch=lane&7; u32x4 v=*(const u32x4*)(stg+row*64+ch*8);
      if(EPI==2){ const u32x4 a=*(const u32x4*)((const bf16*)(shm+LDS_X)+wid*2048+row*64+ch*8);
        #pragma unroll
        for(int e=0;e<4;++e){ const float al=__uint_as_float(a[e]<<16),ah=__uint_as_float(a[e]&0xffff0000u),bl=__uint_as_float(v[e]<<16),bh=__uint_as_float(v[e]&0xffff0000u); v[e]=cvtpk_s(al-lam*bl,ah-lam*bh);} }
      ATTN_STORE16(Ow+(long)row*DM+ch*8,v);} } }
  asm volatile("s_waitcnt lgkmcnt(0)\n\ts_barrier":::"memory");
  #undef DMA_K
  #undef DMA_V
  #undef CMASK
  #undef ADDB
  #undef CIN
  #undef START
  #undef RESC
  #undef ROT
}
constexpr int ATTN_LDS_BYTES=LDS_TOTAL;
__device__ __forceinline__ void fox_bias_scan(char*shm,const float*lf){
  const int tid=otid(),lane=tid&63; const int wid=__builtin_amdgcn_readfirstlane(tid>>6);
  float*nb=(float*)(shm+LDS_X); float*wt=(float*)(shm+LDS_WS);
  const f32x4_t a=*(const f32x4_t*)(lf+8*tid), b=*(const f32x4_t*)(lf+8*tid+4);
  float p[8]; p[0]=a[0];p[1]=p[0]+a[1];p[2]=p[1]+a[2];p[3]=p[2]+a[3];p[4]=p[3]+b[0];p[5]=p[4]+b[1];p[6]=p[5]+b[2];p[7]=p[6]+b[3];
  const float tot=p[7]; float inc=tot;
  #pragma unroll
  for(int o=1;o<64;o<<=1){const float t=__shfl_up(inc,o); if(lane>=o)inc+=t;}
  if(lane==63)wt[wid]=inc;
  __syncthreads();
  float off=inc-tot; for(int w=0;w<wid;++w)off+=wt[w];
  const float L2E=1.4426950408889634f;
  *(f32x4_t*)(nb+8*tid)=(f32x4_t){-(off+p[0])*L2E,-(off+p[1])*L2E,-(off+p[2])*L2E,-(off+p[3])*L2E};
  *(f32x4_t*)(nb+8*tid+4)=(f32x4_t){-(off+p[4])*L2E,-(off+p[5])*L2E,-(off+p[6])*L2E,-(off+p[7])*L2E};
  __syncthreads();
}
template<int MODE> __device__ __forceinline__ void attn_phase2(char*lds,const bf16*Q,const bf16*K,const bf16*V,bf16*O,int G,int bx,const float*LFT,float lam,unsigned*qcnt,volatile unsigned*qword,const float*qg,const float*kg){
  if(MODE!=0){
    const int vcu=(bx%8)*(G/8)+bx/8; const int s=vcu&1,g=vcu>>1; const int b=g>>4;
    for(int i=0;i<8;++i){
      const int p=i>>1; const int qb=(i&1)?4*p+3-s:4*p+s;
      if(MODE==2){ const int h=g&15; attn_unit<8,MODE,0>(b,h,h,h,qb,Q,K,V,O,lds,0.f); }
      else { const int hh=(g&15)>>1,vh=g&1; attn_unit<8,1,1>(b,2*hh,2*hh+vh,2*hh+vh,qb,Q,K,V,O,lds,lam); attn_unit<8,1,2>(b,2*hh+1,2*hh+vh,2*hh+vh,qb,Q,K,V,O,lds,lam); }
    }
  } else {
    float gqm=0.f,gkm=0.f; for(int i=0;i<D;++i){gqm=fmaxf(gqm,fabsf(qg[i]));gkm=fmaxf(gkm,fabsf(kg[i]));}
    const float thr=200.0f+2.0f*1.01f*(float)D*C2*gqm*gkm;
    const float*nb=(const float*)(lds+LDS_X); int cur=-1;
    for(;;){
      __syncthreads();
      if(threadIdx.x==0) *qword=__hip_atomic_fetch_add(qcnt,1u,__ATOMIC_RELAXED,__HIP_MEMORY_SCOPE_AGENT);
      __syncthreads();
      const int u=__builtin_amdgcn_readfirstlane((int)*qword); if(u>=BATCH*NHEAD*NQB)break;
      const int qb=NQB-1-(u>>7),g=u&127,b=g>>4,h=g&15;
      if(g!=cur){ fox_bias_scan(lds,LFT+(size_t)g*SEQ); cur=g; }
      const float ref=nb[qb*QB]-thr;
      int lo=0,hi=2*qb;
      while(lo<hi){ const int mid=(lo+hi+1)>>1; if(nb[128*mid-1]<ref)lo=mid; else hi=mid-1; }
      const int t0=__builtin_amdgcn_readfirstlane(2*lo);
      attn_unit<8,0,0>(b,h,h,h,qb,Q,K,V,O,lds,0.f,t0);
    }
  }
}
#undef SBAR
#undef WAIT_BAR
}

namespace cg = cooperative_groups;
#define GAS __attribute__((address_space(1)))
#define LAS __attribute__((address_space(3)))
typedef unsigned short bf16;
typedef unsigned v4u __attribute__((ext_vector_type(4)));
typedef unsigned v2u __attribute__((ext_vector_type(2)));
typedef float f32x4 __attribute__((ext_vector_type(4)));
typedef float f32x2 __attribute__((ext_vector_type(2)));
typedef short bf16x8 __attribute__((ext_vector_type(8)));
#define LDS_WAIT() asm volatile("s_waitcnt lgkmcnt(0)" ::: "memory")
__device__ __forceinline__ unsigned f2bf(float f) { unsigned u = __builtin_bit_cast(unsigned, f); return (u + 0x7fffu + ((u >> 16) & 1u)) >> 16; }
__device__ __forceinline__ unsigned pk2(float lo, float hi) { return f2bf(lo) | (f2bf(hi) << 16); }
__device__ __forceinline__ float bflo(unsigned v) { return __uint_as_float(v << 16); }
__device__ __forceinline__ float bfhi(unsigned v) { return __uint_as_float(v & 0xffff0000u); }

constexpr int NWAVES = 8;
constexpr int BATCH = 8, SEQ = 4096, DM = 1024, DFF = 2816, DEPTH = 4;
constexpr int M = BATCH * SEQ;
constexpr size_t MiB = 1u << 20;
constexpr size_t WS_BAR = 0, BAR_ZERO_BYTES = 16384;
constexpr size_t WS_SSQ = 1 * MiB, WS_LFT = 3 * MiB, WS_ROPE = 5 * MiB, WS_WF = 7 * MiB, WS_W = 8 * MiB, FFN_SLOT = 16 * MiB + MiB / 2, WS_WM = WS_W + 8 * FFN_SLOT, MIX_SLOT = 8 * MiB;
constexpr size_t WS_XB = WS_WM + 4 * MIX_SLOT, WS_Q = WS_XB + 64 * MiB, WS_K = WS_Q + 64 * MiB, WS_V = WS_K + 64 * MiB, WS_O = WS_V + 64 * MiB, WS_END = WS_O + 64 * MiB;
static_assert(WS_XB == 172 * MiB && WS_END == 492 * MiB, "ws map");
constexpr int RING_BYTES = 131072, LDS_BYTES = 147456;
constexpr float LAMBDA_INIT = 0.4707130183435842f;
constexpr int N_PHASES = 1 + 4 * 4 + 3 + 3 + 4 + 3;

struct Args { const float* in[33]; float* out; unsigned char* ws; int ph_lo, ph_hi; };

__device__ __forceinline__ float wave_sum(float v) {
#pragma unroll
    for (int o = 1; o < 64; o <<= 1) v += __shfl_xor(v, o);
    return v;
}

__device__ __forceinline__ void wt_item(const float* W0, const float* W1, int ldw, int K, int N, int kind, const float* gain, int gmask, float gscale, bf16* WT, LAS float* scr, int item, int lane) {
    const int nblk = N / 32, kb = item / nblk, nb = item % nblk, k0 = 64 * kb, R0 = 32 * nb;
    const int R = R0 + (lane & 31), pn = R >> 8, p = R & 255;
    const float* src;
    if (kind == 0) src = W0 + R;
    else { const int bj = p >> 7, wc = (p >> 5) & 3, r = p & 31;
        if (kind == 1) src = (bj ? W1 : W0) + (128 * pn + (p & 127));
        else src = W0 + (256 * pn + 64 * wc + 32 * bj + r); }
    float tv[32];
#pragma unroll
    for (int i = 0; i < 32; ++i) { const int kk = 2 * i + (lane >> 5); tv[i] = src[(size_t)(k0 + kk) * ldw]; }
#pragma unroll
    for (int i = 0; i < 32; ++i) { const int kk = 2 * i + (lane >> 5); scr[kk * 33 + (lane & 31)] = tv[i]; }
    LDS_WAIT(); asm volatile("" ::: "memory");
    const int c = lane & 7;
    f32x4 g0 = {gscale, gscale, gscale, gscale}, g1 = g0;
    if (gain) { const int kg = (k0 + 8 * c) & gmask; g0 = *(const f32x4*)(gain + kg) * gscale; g1 = *(const f32x4*)(gain + kg + 4) * gscale; }
#pragma unroll
    for (int j = 0; j < 4; ++j) { const int n = (lane >> 3) + 8 * j; const LAS float* s = scr + (8 * c) * 33 + n;
        v4u o; o.x = pk2(s[0 * 33] * g0[0], s[1 * 33] * g0[1]); o.y = pk2(s[2 * 33] * g0[2], s[3 * 33] * g0[3]); o.z = pk2(s[4 * 33] * g1[0], s[5 * 33] * g1[1]); o.w = pk2(s[6 * 33] * g1[2], s[7 * 33] * g1[3]);
        *(GAS v4u*)(WT + (size_t)(R0 + n) * K + k0 + 8 * c) = o; }
    LDS_WAIT(); asm volatile("" ::: "memory");
}

__device__ __forceinline__ bf16* w_gu(unsigned char* ws, int f) { return (bf16*)(ws + WS_W + (size_t)f * FFN_SLOT); }
__device__ __forceinline__ bf16* w_dn(unsigned char* ws, int f) { return (bf16*)(ws + WS_W + (size_t)f * FFN_SLOT + 11 * MiB); }
__device__ __forceinline__ bf16* w_mi(unsigned char* ws, int L) { return (bf16*)(ws + WS_WM + (size_t)L * MIX_SLOT); }
__device__ __forceinline__ bf16* w_mo(unsigned char* ws, int L) { return (bf16*)(ws + WS_WM + (size_t)L * MIX_SLOT + 6 * MiB); }

__device__ __forceinline__ void prologue(const Args& args, LAS unsigned char* lds, int vcu, int G, int wave, int lane, int tid) {
    unsigned char* ws = args.ws;
    LAS float* scr = (LAS float*)(lds + wave * 16384);
    const int gw = vcu * NWAVES + wave, NGW = G * NWAVES;
    int it = gw, base = 0;
    for (int job = 0; job < 24; ++job) {
        const float* W0; const float* W1; int ldw, K, N, kind, gmask = 1023; bf16* Bt; const float* gain = nullptr; float gscale = 1.0f;
        if (job < 16) { const int f = job >> 1, L = f >> 1, which = f & 1;
            if (!(job & 1)) { W0 = (which ? args.in[8] : args.in[5]) + (size_t)L * DM * DFF; W1 = (which ? args.in[9] : args.in[6]) + (size_t)L * DM * DFF; ldw = DFF; K = DM; N = 2 * DFF; kind = 1;
                gain = (which ? args.in[4] : args.in[2]) + L * DM; Bt = w_gu(ws, f); }
            else { W0 = (which ? args.in[10] : args.in[7]) + (size_t)L * DM * DFF; W1 = W0; ldw = DM; K = DFF; N = DM; kind = 0; Bt = w_dn(ws, f); } }
        else { const int L = (job - 16) >> 1, mk = L % 3, idx = L / 3; K = DM;
            if (!(job & 1)) { gain = args.in[3] + L * DM; Bt = w_mi(ws, L);
                if (mk == 0) { W0 = args.in[11] + (size_t)idx * DM * 3088; W1 = W0; ldw = 3088; N = 3072; kind = 2; }
                else if (mk == 1) { W0 = args.in[16]; W1 = args.in[16] + 1024; ldw = 2048; N = 2048; kind = 1; }
                else { W0 = args.in[24]; W1 = W0; ldw = 3072; N = 3072; kind = 2; } }
            else { N = DM; ldw = DM; kind = 0; Bt = w_mo(ws, L);
                if (mk == 0) W0 = args.in[15] + (size_t)idx * DM * DM; else if (mk == 1) W0 = args.in[22]; else { W0 = args.in[32]; gain = args.in[31]; gmask = 127; gscale = 1.0f - LAMBDA_INIT; }
                W1 = W0; } }
        const int items = (K / 64) * (N / 32);
        for (; it < base + items; it += NGW) wt_item(W0, W1, ldw, K, N, kind, gain, gmask, gscale, Bt, scr, it - base, lane);
        base += items;
    }
    { const float* x = args.in[0]; bf16* XB = (bf16*)(ws + WS_XB); float* SSQ = (float*)(ws + WS_SSQ);
        for (int m0 = gw; m0 < M; m0 += 2 * NGW) {
            f32x4 v[2][4]; float s[2];
#pragma unroll
            for (int h = 0; h < 2; ++h) { const int m = m0 + h * NGW; const GAS f32x4* xr = (const GAS f32x4*)(x + (size_t)(m < M ? m : m0) * DM) + lane;
#pragma unroll
                for (int j = 0; j < 4; ++j) v[h][j] = xr[64 * j]; }
#pragma unroll
            for (int h = 0; h < 2; ++h) { const int m = m0 + h * NGW; float t = 0.f;
#pragma unroll
                for (int j = 0; j < 4; ++j) t += (v[h][j].x * v[h][j].x + v[h][j].y * v[h][j].y) + (v[h][j].z * v[h][j].z + v[h][j].w * v[h][j].w);
                s[h] = wave_sum(t);
                if (m < M) { GAS unsigned long long* o8 = (GAS unsigned long long*)(XB + (size_t)m * DM) + lane;
#pragma unroll
                    for (int j = 0; j < 4; ++j) o8[64 * j] = (unsigned long long)pk2(v[h][j].x, v[h][j].y) | ((unsigned long long)pk2(v[h][j].z, v[h][j].w) << 32);
                    if (lane < 4) SSQ[(size_t)m * 4 + lane] = lane == 0 ? s[h] : 0.f; } }
        } }
    { const int* pos = (const int*)args.in[1]; float* RT = (float*)(ws + WS_ROPE);
        for (int e = vcu * 512 + tid; e < M * 8; e += G * 512) {
            const int m = e >> 3, i = e & 7;
            const float fr = i == 0 ? 1.0f : i == 1 ? 0.1939227432012558f : i == 2 ? 0.03760603070259094f : i == 3 ? 0.007292664609849453f : i == 4 ? 0.0014142135623842478f : i == 5 ? 0.00027424818836152554f : i == 6 ? 5.318296098266728e-05f : 1.0313386155758053e-05f;
            const float af = (float)pos[m] * fr; const double a = (double)af;
            const double nq = __builtin_rint(a * 0.6366197723675814);
            double r = __builtin_fma(-nq, 1.5707963267948966, a); r = __builtin_fma(-nq, 6.123233995736766e-17, r);
            const double r2 = r * r;
            double sp = 1.0 / 6227020800.0; sp = sp * r2 - 1.0 / 39916800.0; sp = sp * r2 + 1.0 / 362880.0; sp = sp * r2 - 1.0 / 5040.0; sp = sp * r2 + 1.0 / 120.0; sp = sp * r2 - 1.0 / 6.0; sp = sp * r2 * r + r;
            double cp = -1.0 / 87178291200.0; cp = cp * r2 + 1.0 / 479001600.0; cp = cp * r2 - 1.0 / 3628800.0; cp = cp * r2 + 1.0 / 40320.0; cp = cp * r2 - 1.0 / 720.0; cp = cp * r2 + 1.0 / 24.0; cp = cp * r2 - 0.5; cp = cp * r2 + 1.0;
            const int q = ((int)nq) & 3;
            const double sn = (q == 0) ? sp : (q == 1) ? cp : (q == 2) ? -sp : -cp;
            const double cs = (q == 0) ? cp : (q == 1) ? -sp : (q == 2) ? -cp : sp;
            RT[(size_t)m * 16 + i] = (float)cs; RT[(size_t)m * 16 + 8 + i] = (float)sn;
        } }
    { bf16* WF = (bf16*)(ws + WS_WF);
        for (int e = vcu * 512 + tid; e < 2 * 16 * 1024; e += G * 512) {
            const int idx = e >> 14, h = (e >> 10) & 15, k = e & 1023; const int L = idx * 3;
            WF[e] = (bf16)f2bf(args.in[3][L * DM + k] * args.in[11][(size_t)idx * DM * 3088 + (size_t)k * 3088 + 3072 + h]);
        } }
}

__device__ __forceinline__ void flogit_tasks(const bf16* XB, const bf16* WfT, const float* ssq, const float* b_f, float* LFT, int gw, int NGW, int lane) {
    const int fr = lane & 15, fq = lane >> 4;
    for (int task = gw; task < M / 16; task += NGW) {
        const int row0 = task * 16;
        const bf16x8* ap = (const bf16x8*)(XB + (size_t)(row0 + fr) * DM + 8 * fq);
        const bf16x8* bp = (const bf16x8*)(WfT + (size_t)fr * DM + 8 * fq);
        f32x4 acc = {0.f, 0.f, 0.f, 0.f};
#pragma unroll 8
        for (int kk = 0; kk < 32; ++kk) acc = __builtin_amdgcn_mfma_f32_16x16x32_bf16(ap[kk * 4], bp[kk * 4], acc, 0, 0, 0);
        const float bf = b_f[fr]; f32x4 lf;
#pragma unroll
        for (int i = 0; i < 4; ++i) { const float z = acc[i] * pg8::row_rstd(ssq, row0 + 4 * fq + i) + bf;
            const float e = __expf(-fabsf(z)); lf[i] = fminf(z, 0.f) - __logf(1.0f + e); }
        const int b = row0 >> 12, s = (row0 & 4095) + 4 * fq;
        *(f32x4*)(LFT + ((size_t)(b * 16 + fr) * SEQ + s)) = lf;
    }
}

__device__ __forceinline__ void conv_phase(LAS unsigned char* lds, const bf16* Gb, bf16* Cb, const float* wdw, const float* bdw, const float* lng, const float* lnb, int vcu, int G, int tid, int wave, int lane) {
    LAS float* T = (LAS float*)lds;
    const int c0 = 2 * tid;
    float w0[31], w1[31];
#pragma unroll
    for (int j = 0; j < 31; ++j) { const f32x2 t = *(const f32x2*)(wdw + j * DM + c0); w0[j] = t.x; w1[j] = t.y; }
    const f32x2 bd = *(const f32x2*)(bdw + c0);
    const int per = (2048 + G - 1) / G;
    for (int k = 0; k < per; ++k) {
        const int unit = vcu * per + k; if (unit >= 2048) break;
        const int b = unit >> 8, t0 = (unit & 255) * 16; const size_t rowbase = (size_t)b * SEQ;
        float a0[16], a1[16];
#pragma unroll
        for (int o = 0; o < 16; ++o) { a0[o] = bd.x; a1[o] = bd.y; }
#pragma unroll
        for (int i = 0; i < 46; ++i) {
            const int t = t0 - 30 + i;
            unsigned v = 0u; if (t >= 0) v = *(const unsigned*)(Gb + (rowbase + t) * DM + c0);
            const float x0 = bflo(v), x1 = bfhi(v);
#pragma unroll
            for (int o = 0; o < 16; ++o) { const int j = i - o; if (j >= 0 && j <= 30) { a0[o] += w0[j] * x0; a1[o] += w1[j] * x1; } }
        }
#pragma unroll
        for (int o = 0; o < 16; ++o) *(LAS f32x2*)(T + o * DM + c0) = (f32x2){a0[o], a1[o]};
        __syncthreads();
#pragma unroll
        for (int rr = 0; rr < 2; ++rr) { const int o = 2 * wave + rr;
            f32x4 v[4]; float s = 0.f;
#pragma unroll
            for (int q = 0; q < 4; ++q) { v[q] = *(const LAS f32x4*)(T + o * DM + 4 * lane + 256 * q); s += (v[q].x + v[q].y) + (v[q].z + v[q].w); }
            const float mean = wave_sum(s) * (1.0f / DM); float s2 = 0.f;
#pragma unroll
            for (int q = 0; q < 4; ++q) { v[q] = v[q] - mean; s2 += (v[q].x * v[q].x + v[q].y * v[q].y) + (v[q].z * v[q].z + v[q].w * v[q].w); }
            const float rstd = pg8::rsq_(wave_sum(s2) * (1.0f / DM) + 1e-6f);
            bf16* orow = Cb + (rowbase + t0 + o) * DM;
#pragma unroll
            for (int q = 0; q < 4; ++q) { const f32x4 g = *(const f32x4*)(lng + 4 * lane + 256 * q), bb = *(const f32x4*)(lnb + 4 * lane + 256 * q);
                f32x4 y = v[q] * rstd * g + bb;
#pragma unroll
                for (int e = 0; e < 4; ++e) y[e] = y[e] * pg8::sigm_(y[e]);
                v2u w; w.x = pk2(y[0], y[1]); w.y = pk2(y[2], y[3]); *(v2u*)(orow + 4 * lane + 256 * q) = w; }
        }
        __syncthreads();
    }
}

__device__ __forceinline__ void subnorm_phase(const bf16* Ob, bf16* Nb, int gw, int NGW, int lane) {
    for (int m = gw; m < M; m += NGW) {
        const v4u* ip = (const v4u*)(Ob + (size_t)m * DM + 16 * lane); const v4u a = ip[0], b = ip[1];
        float f[16];
#pragma unroll
        for (int e = 0; e < 4; ++e) { f[2 * e] = bflo(a[e]); f[2 * e + 1] = bfhi(a[e]); f[8 + 2 * e] = bflo(b[e]); f[8 + 2 * e + 1] = bfhi(b[e]); }
        float s = 0.f;
#pragma unroll
        for (int e = 0; e < 16; ++e) s += f[e] * f[e];
        s += __shfl_xor(s, 1); s += __shfl_xor(s, 2); s += __shfl_xor(s, 4);
        const float r = pg8::rsq_(s * (1.0f / 128.0f) + 1e-6f);
        v4u oa, ob;
#pragma unroll
        for (int e = 0; e < 4; ++e) { oa[e] = pk2(f[2 * e] * r, f[2 * e + 1] * r); ob[e] = pk2(f[8 + 2 * e] * r, f[8 + 2 * e + 1] * r); }
        v4u* op = (v4u*)(Nb + (size_t)m * DM + 16 * lane); op[0] = oa; op[1] = ob;
    }
}

#define XB_TMO      128
#define XB_XCNT(j)  (256  + 64 * (j))
#define XB_XSUB(j)  (1280 + 64 * (j))
#define XB_XGEN(j)  (2304 + 64 * (j))
#define XB_TOP      3328
#define XB_TOPGEN   3392
#define XCD_BAR_WORDS 3456
#define XB_SPIN_CAP (1u << 18)

__device__ __forceinline__ unsigned xb_ld(unsigned* p)              { return __hip_atomic_load(p, __ATOMIC_RELAXED, __HIP_MEMORY_SCOPE_AGENT); }
__device__ __forceinline__ unsigned xb_add(unsigned* p, unsigned v) { return __hip_atomic_fetch_add(p, v, __ATOMIC_RELAXED, __HIP_MEMORY_SCOPE_AGENT); }
__device__ __forceinline__ unsigned xb_xcc_id() { return (unsigned)__builtin_amdgcn_s_getreg((3 << 11) | 20) & 0xFu; }
#define XB_SPIN(cond, bar) do { unsigned _sp = 0; while (cond) { __builtin_amdgcn_s_sleep(1); \
    if ((++_sp & 255u) == 0u) { if (xb_ld(&(bar)[XB_TMO])) break; if (_sp > XB_SPIN_CAP) { atomicAdd(&(bar)[XB_TMO], 1u); break; } } } } while (0)

struct XcdBarrier {
    unsigned* bar; unsigned x;
    volatile LAS unsigned* st;
};

__device__ __forceinline__ XcdBarrier xcd_barrier_post(unsigned* bar, volatile LAS unsigned* st) {
    XcdBarrier b; b.bar = bar; b.x = xb_xcc_id(); b.st = st;
    if (threadIdx.x == 0) (void)xb_add(&bar[XB_XCNT(b.x)], 1u);
    return b;
}
__device__ __forceinline__ void xcd_barrier_complete(unsigned* bar, unsigned x, unsigned& nloc, unsigned& nx) {
    const unsigned G = gridDim.x * gridDim.y * gridDim.z;
    unsigned sum, cnt, mine, sp = 0u;
    for (;;) {
        sum = 0u; cnt = 0u; mine = 0u;
#pragma unroll
        for (unsigned j = 0; j < 16; ++j) { const unsigned c = xb_ld(&bar[XB_XCNT(j)]); sum += c; cnt += (c > 0u) ? 1u : 0u; mine = (j == x) ? c : mine; }
        if (sum == G) break;
        __builtin_amdgcn_s_sleep(1);
        if ((++sp & 255u) == 0u) { if (xb_ld(&bar[XB_TMO])) break; if (sp > XB_SPIN_CAP) { atomicAdd(&bar[XB_TMO], 1u); break; } }
    }
    nloc = mine > 0u ? mine : 1u; nx = cnt > 0u ? cnt : 1u;
}

__device__ __forceinline__ void xcd_barrier(const XcdBarrier& b) {
    asm volatile("s_waitcnt vmcnt(0)" ::: "memory");
    __syncthreads();
    if (threadIdx.x == 0) {
        unsigned* bar = b.bar;
        __builtin_amdgcn_s_waitcnt(0);
        unsigned nloc = b.st[0], nx = b.st[1];
        if (nloc == 0u) { xcd_barrier_complete(bar, b.x, nloc, nx); b.st[0] = nloc; b.st[1] = nx; }
        const unsigned old = xb_add(&bar[XB_XSUB(b.x)], 1u);
        const unsigned gen = old / nloc;
        if (old + 1u == (gen + 1u) * nloc) {
            __builtin_amdgcn_fence(__ATOMIC_RELEASE, "agent");
            asm volatile("s_waitcnt vmcnt(0)" ::: "memory");
            const unsigned og = xb_add(&bar[XB_TOP], 1u);
            const unsigned tg = og / nx;
            if (og + 1u == (tg + 1u) * nx) xb_add(&bar[XB_TOPGEN], 1u);
            else XB_SPIN(xb_ld(&bar[XB_TOPGEN]) == tg, bar);
            __builtin_amdgcn_fence(__ATOMIC_ACQUIRE, "agent");
            xb_add(&bar[XB_XGEN(b.x)], 1u);
            asm volatile("s_waitcnt vmcnt(0)" ::: "memory");
        } else {
            XB_SPIN(xb_ld(&bar[XB_XGEN(b.x)]) == gen, bar);
            __builtin_amdgcn_fence(__ATOMIC_ACQUIRE, "agent");
            asm volatile("s_waitcnt vmcnt(0)" ::: "memory");
        }
    }
    __syncthreads();
}

__global__ void __launch_bounds__(NWAVES * 64, 2) mega_fwd(Args args) {
    extern __shared__ __attribute__((aligned(16))) unsigned char lds[];
    cg::grid_group grid = cg::this_grid();
    LAS unsigned char* L3 = (LAS unsigned char*)lds;
#define TID_DEFS const int tid = otid(), lane = tid & 63, wave = __builtin_amdgcn_readfirstlane(tid >> 6); const int gw = vcu * NWAVES + wave, NGW = G * NWAVES; (void)lane; (void)gw; (void)NGW;
    const int G = gridDim.x; const int bx = blockIdx.x; const int vcu = (G % 8 == 0) ? (bx % 8) * (G / 8) + bx / 8 : bx;
    unsigned char* ws = args.ws;
    bf16* XB = (bf16*)(ws + WS_XB); bf16* QB_ = (bf16*)(ws + WS_Q); bf16* KB = (bf16*)(ws + WS_K); bf16* VB = (bf16*)(ws + WS_V); bf16* OB = (bf16*)(ws + WS_O);
    float* SSQ = (float*)(ws + WS_SSQ); float* LFT = (float*)(ws + WS_LFT); const float* ROPE = (const float*)(ws + WS_ROPE);
    const int lo = args.ph_lo, hi = args.ph_hi; int ph = 0;
    volatile LAS unsigned* MISC = (volatile LAS unsigned*)(L3 + RING_BYTES + 2048);
    if (threadIdx.x < 16) MISC[threadIdx.x] = 0u;
    __syncthreads();
    XcdBarrier xbar = xcd_barrier_post((unsigned*)(ws + WS_BAR), MISC);
#define IN_PH() (lo <= ph && ph < hi)
#ifndef PROBE_SYNC
#define PROBE_SYNC 1
#endif
#ifndef PROBE_ATT
#define PROBE_ATT 1
#endif
#ifndef PROBE_RES
#define PROBE_RES 1
#endif
#ifndef PROBE_NOEPI
#define PROBE_NOEPI 0
#endif
#ifndef PROBE_FOXNB
#define PROBE_FOXNB 0
#endif
#ifndef PROBE_IN
#define PROBE_IN 1
#endif
#ifndef PROBE_PRO
#define PROBE_PRO 1
#endif
#ifndef PROBE_MISC
#define PROBE_MISC 1
#endif
#ifndef PROBE_GU
#define PROBE_GU 1
#endif
#define END_PH() do { if (lo <= ph && ph + 1 < hi) { for (int q_ = 0; q_ < PROBE_SYNC; ++q_) { if (lo < 0) grid.sync(); else xcd_barrier(xbar); } } ++ph; } while (0)

#ifndef NO_PRO
    if (IN_PH()) { TID_DEFS for (int rep_ = 0; rep_ < PROBE_PRO; ++rep_) prologue(args, L3, vcu, G, wave, lane, tid); }
#endif
    END_PH();

    for (int st = 0; st < 3 * DEPTH; ++st) {
        const int L = st / 3, r3 = st % 3, mk = L % 3, idx = L / 3;
        const int nsub = (r3 != 1) ? 2 : (mk == 2 ? 4 : 3);
        for (int sp = 0; sp < nsub; ++sp) {
            if (IN_PH()) {
                TID_DEFS
                if (sp == 0 || sp == nsub - 1) {
                    pg8::Gemm g; pg8::EpiP E;
                    E.kind = 0; E.ldo = 0; E.O = nullptr; E.Kd = nullptr; E.Vd = nullptr; E.ssq_in = SSQ; E.bias = nullptr; E.qg = nullptr; E.kg = nullptr; E.rope = ROPE;
                    E.base = nullptr; E.out = args.out; E.xb = XB; E.xbw = XB; E.ssq_out = SSQ; E.alpha = 1.0f; E.qscale = attn_body::C2;
                    g.M = M;
                    if (sp == 0) {
                        g.A = XB; g.K = DM;
                        if (r3 != 1) { const int f = 2 * L + (r3 == 2); g.Bt = w_gu(ws, f); g.N = 2 * DFF; E.kind = 0; E.O = QB_; E.ldo = DFF; }
                        else if (mk == 0) { g.Bt = w_mi(ws, L); g.N = 3072; E.kind = 2; E.O = QB_; E.Kd = KB; E.Vd = VB; E.qg = args.in[13] + idx * 64; E.kg = args.in[14] + idx * 64; }
                        else if (mk == 1) { g.Bt = w_mi(ws, L); g.N = 2048; E.kind = 1; E.O = QB_; E.ldo = DM; E.bias = args.in[17]; }
                        else { g.Bt = w_mi(ws, L); g.N = 3072; E.kind = 3; E.O = QB_; E.Kd = KB; E.Vd = VB; E.qg = args.in[25]; E.kg = args.in[26]; }
                    } else {
                        E.kind = 4; g.N = DM; E.base = (st == 0) ? args.in[0] : (const float*)args.out;
#if RESID_BF16
                        E.out = (st == 3 * DEPTH - 1) ? args.out : nullptr;
#endif
                        if (r3 != 1) { const int f = 2 * L + (r3 == 2); g.A = QB_; g.K = DFF; g.Bt = w_dn(ws, f); E.alpha = 0.5f; }
                        else { g.K = DM; g.Bt = w_mo(ws, L);
                            if (mk == 0) g.A = OB; else if (mk == 1) { g.A = KB; E.bias = args.in[23]; } else g.A = QB_; }
                    }
                    const int nrep = (sp == 0 && r3 != 1) ? PROBE_GU : ((sp == 0 && r3 == 1) ? PROBE_IN : PROBE_RES);
                    const int kind0 = E.kind;
                    for (int rep_ = 0; rep_ < nrep; ++rep_) {
                    E.kind = (PROBE_NOEPI && rep_ + 1 < nrep) ? 9 : kind0;
                    if (sp != 0) { const bool dry = rep_ + 1 < nrep; E.xbw = dry ? ((r3 != 1) ? OB : VB) : XB; E.ssq_out = dry ? LFT : SSQ; }
                    __syncthreads();
                    if (tid == 0) { LAS pg8::EpiP* P = (LAS pg8::EpiP*)(L3 + RING_BYTES + 1024);
                        P->kind = E.kind; P->ldo = E.ldo; P->O = E.O; P->Kd = E.Kd; P->Vd = E.Vd; P->ssq_in = E.ssq_in; P->bias = E.bias; P->qg = E.qg; P->kg = E.kg; P->rope = E.rope;
                        P->base = E.base; P->out = E.out; P->xb = E.xb; P->xbw = E.xbw; P->ssq_out = E.ssq_out; P->alpha = E.alpha; P->qscale = E.qscale; }
                    __syncthreads();
                    pg8::EpiAny EA; EA.P = (const LAS pg8::EpiP*)(L3 + RING_BYTES + 1024); EA.xl = (LAS float*)(L3 + RING_BYTES + 4096);
                    pg8::StaticOrder S; S.init(M, g.N, G, bx);
#ifndef NO_GEMM
                    pg8::gemm_phase<pg8::EpiAny, pg8::StaticOrder, true, true>(L3, g, S, EA);
#endif
                    }
#ifndef NO_FLOG
                    if (sp == 0 && r3 == 1 && mk == 0)
                      for (int rep_ = 0; rep_ < PROBE_MISC; ++rep_)
                        flogit_tasks(XB, (const bf16*)(ws + WS_WF) + (size_t)idx * 16 * DM, SSQ, args.in[12] + idx * 16, LFT, gw, NGW, lane);
#endif
                } else if (mk == 0) {
#if PROBE_FOXNB
                    attn_body::attn_phase2<2>((char*)lds, (const attn_body::bf16*)QB_, (const attn_body::bf16*)KB, (const attn_body::bf16*)VB, (attn_body::bf16*)OB, G, bx, LFT, 0.f, nullptr, nullptr, nullptr, nullptr);
#endif
#ifndef NO_ATT0
                    for (int rep_ = 0; rep_ < PROBE_ATT; ++rep_)
                    attn_body::attn_phase2<0>((char*)lds, (const attn_body::bf16*)QB_, (const attn_body::bf16*)KB, (const attn_body::bf16*)VB, (attn_body::bf16*)OB, G, bx, LFT, 0.f,
                        (unsigned*)(ws + WS_BAR + 14336 + 256 * (idx * PROBE_ATT + rep_)), (volatile unsigned*)(lds + RING_BYTES + 3072), args.in[13] + idx * 64, args.in[14] + idx * 64);
#endif
                } else if (mk == 1) {
#ifndef NO_CONV
                    for (int rep_ = 0; rep_ < PROBE_MISC; ++rep_)
                    conv_phase(L3, QB_, KB, args.in[18], args.in[19], args.in[20], args.in[21], vcu, G, tid, wave, lane);
#endif
                } else if (sp == 1) {
                    float s1 = 0.f, s2 = 0.f;
                    for (int i = 0; i < 64; ++i) { s1 += args.in[27][i] * args.in[28][i]; s2 += args.in[29][i] * args.in[30][i]; }
                    const float lam = __expf(s1) - __expf(s2) + LAMBDA_INIT;
#ifndef NO_ATT1
                    for (int rep_ = 0; rep_ < PROBE_ATT; ++rep_)
                    attn_body::attn_phase2<1>((char*)lds, (const attn_body::bf16*)QB_, (const attn_body::bf16*)KB, (const attn_body::bf16*)VB, (attn_body::bf16*)OB, G, bx, LFT, lam, nullptr, nullptr, nullptr, nullptr);
#endif
                } else {
                    for (int rep_ = 0; rep_ < PROBE_MISC; ++rep_) subnorm_phase(OB, QB_, gw, NGW, lane);
                }
            }
            END_PH();
        }
    }
#undef IN_PH
#undef END_PH
}

#ifndef MK_MULTI
#define MK_MULTI 0
#endif
extern "C" void kernel_launch(void* const* d_in, const int* in_sizes, int n_in, void* d_out, int out_size, void* d_ws, size_t ws_size, hipStream_t stream) {
    static int grid = 0;
    if (grid == 0) {
        if (n_in != 33 || in_sizes[0] != M * DM || out_size != M * DM || ws_size < WS_END) { fprintf(stderr, "kernel_launch: unexpected shapes: n_in %d in0 %d out %d ws %zu (need %zu)\n", n_in, n_in > 0 ? in_sizes[0] : -1, out_size, ws_size, (size_t)WS_END); grid = -1; return; }
        int dev = 0, cus = 0, per_cu = 0;
        hipGetDevice(&dev); hipDeviceGetAttribute(&cus, hipDeviceAttributeMultiprocessorCount, dev);
        if (hipFuncSetAttribute((const void*)mega_fwd, hipFuncAttributeMaxDynamicSharedMemorySize, LDS_BYTES) != hipSuccess) { fprintf(stderr, "kernel_launch: hipFuncSetAttribute failed\n"); grid = -1; return; }
        hipOccupancyMaxActiveBlocksPerMultiprocessor(&per_cu, (const void*)mega_fwd, NWAVES * 64, LDS_BYTES);
        (void)hipGetLastError();
        grid = cus;
        if (grid != 256 || per_cu < 1) fprintf(stderr, "kernel_launch: note: %d CUs, occupancy query %d; built for 256 CUs x 1 workgroup\n", cus, per_cu);
        if (grid != 256) { grid = -1; return; }
    }
    if (grid < 0) return;
    if (hipMemsetAsync((char*)d_ws + WS_BAR, 0, BAR_ZERO_BYTES, stream) != hipSuccess) { fprintf(stderr, "kernel_launch: memset failed\n"); return; }
    Args a{};
    for (int i = 0; i < 33; ++i) a.in[i] = (const float*)d_in[i];
    a.out = (float*)d_out; a.ws = (unsigned char*)d_ws;
#if MK_MULTI
    for (int p = 0; p < N_PHASES; ++p) { a.ph_lo = p; a.ph_hi = p + 1; hipLaunchKernelGGL(mega_fwd, dim3(grid), dim3(NWAVES * 64), LDS_BYTES, stream, a); }
#else
    a.ph_lo = 0; a.ph_hi = N_PHASES;
    void* kargs[] = {&a};
    const hipError_t e = hipLaunchCooperativeKernel((const void*)mega_fwd, dim3(grid), dim3(NWAVES * 64), kargs, LDS_BYTES, stream);
    if (e != hipSuccess) fprintf(stderr, "kernel_launch: cooperative launch failed: %s\n", hipGetErrorString(e));
#endif
}
```
